# Optimizing an MI355X kernel written in HIP

```python
import jax, jax.numpy as jnp
from jax import lax
import numpy as np

D_MODEL = 1024
BATCH = 8
SEQ = 4096
DEPTH = 4

N_EVEN = (DEPTH + 1) // 2
N_ODD = DEPTH // 2

SB_HEADS = 8
SB_HEAD_DIM = 64
SB_WIDTH = SB_HEADS * SB_HEAD_DIM
Q_BLOCK = 128
CONV_WIDTH = D_MODEL // 2
CONV_KERNEL = 31
EVEN_IN = 3 * SB_WIDTH + 2 * CONV_WIDTH
EVEN_MIX = SB_WIDTH + CONV_WIDTH
POOL_WINDOWS = (2, 4, 8, 16)
POOL_GROUP = D_MODEL // len(POOL_WINDOWS)
N_EXPERTS = 64
TOP_K = 8
N_GROUPS = 8
TOPK_GROUPS = 4
EXPERT_FF = 256
SHARED_FF = 256
ROUTED_SCALE = 2.5
MOE_BLOCK = 256
EPS = 1e-6

kernel_name = "hybrid_sb_conformer_pool_moe_adaln"


def rmsnorm(x, g):
    xf = x.astype(jnp.float32)
    y = xf * lax.rsqrt(jnp.mean(xf * xf, axis=-1, keepdims=True) + EPS)
    return (y * g.astype(jnp.float32)).astype(x.dtype)


def layernorm(x, g, b):
    xf = x.astype(jnp.float32)
    mu = jnp.mean(xf, axis=-1, keepdims=True)
    var = jnp.mean(jnp.square(xf - mu), axis=-1, keepdims=True)
    y = (xf - mu) * lax.rsqrt(var + EPS)
    return (y * g.astype(jnp.float32) + b.astype(jnp.float32)).astype(x.dtype)


def modulate(h, shift, scale):
    return h * (1 + scale) + shift


def stick_breaking_attention(q, k, v):
    S = q.shape[1]
    scale = SB_HEAD_DIM ** -0.5
    outs = []
    for i in range(S // Q_BLOCK):
        t0, t1 = i * Q_BLOCK, (i + 1) * Q_BLOCK
        qb, kb, vb = q[:, t0:t1], k[:, :t1], v[:, :t1]
        z = jnp.einsum('bqhd,bkhd->bhqk', qb, kb).astype(jnp.float32) * scale
        causal = jnp.arange(t1)[None, :] < jnp.arange(t0, t1)[:, None]
        log_beta = jax.nn.log_sigmoid(z)
        log_1m = jnp.where(causal, jax.nn.log_sigmoid(-z), 0.0)
        log_rem = lax.cumsum(log_1m, axis=3, reverse=True) - log_1m
        a = jnp.where(causal, jnp.exp(log_beta + log_rem), 0.0)
        outs.append(jnp.einsum('bhqk,bkhd->bqhd', a.astype(vb.dtype), vb))
    return jnp.concatenate(outs, axis=1)


def causal_depthwise_conv(u, w, b):
    y = lax.conv_general_dilated(u, w, window_strides=(1,), padding=[(CONV_KERNEL - 1, 0)],
                                 dimension_numbers=('NWC', 'WIO', 'NWC'),
                                 feature_group_count=u.shape[-1])
    return y + b


def even_mixer(h, w_in, dw_w, dw_b, ln_g, ln_b, w_out):
    B, S, _ = h.shape
    proj = h @ w_in
    q = proj[..., 0:SB_WIDTH].reshape(B, S, SB_HEADS, SB_HEAD_DIM)
    k = proj[..., SB_WIDTH:2 * SB_WIDTH].reshape(B, S, SB_HEADS, SB_HEAD_DIM)
    v = proj[..., 2 * SB_WIDTH:3 * SB_WIDTH].reshape(B, S, SB_HEADS, SB_HEAD_DIM)
    a_val = proj[..., 3 * SB_WIDTH:3 * SB_WIDTH + CONV_WIDTH]
    a_gate = proj[..., 3 * SB_WIDTH + CONV_WIDTH:]
    att = stick_breaking_attention(q, k, v).reshape(B, S, SB_WIDTH)
    u = a_val * jax.nn.sigmoid(a_gate)
    u = causal_depthwise_conv(u, dw_w, dw_b)
    u = jax.nn.silu(layernorm(u, ln_g, ln_b))
    return jnp.concatenate([att, u], axis=-1) @ w_out


def trailing_mean(u, w):
    S = u.shape[1]
    cs = jnp.cumsum(u.astype(jnp.float32), axis=1)
    prev = jnp.pad(cs, ((0, 0), (w, 0), (0, 0)))[:, :S]
    cnt = jnp.minimum(jnp.arange(1, S + 1), w).astype(jnp.float32)[None, :, None]
    return ((cs - prev) / cnt).astype(u.dtype)


def odd_mixer(h, w_in, w_grp, ch_scale, w_out):
    u = h @ w_in
    outs = []
    for gi, w in enumerate(POOL_WINDOWS):
        ug = u[..., gi * POOL_GROUP:(gi + 1) * POOL_GROUP]
        pooled = trailing_mean(ug, w) - ug
        outs.append(jnp.einsum('bsc,cd->bsd', pooled, w_grp[gi]))
    y = jnp.concatenate(outs, axis=-1) * ch_scale
    return y @ w_out


def route(xf, w_router, bias):
    N = xf.shape[0]
    per_group = N_EXPERTS // N_GROUPS
    scores = jax.nn.sigmoid(xf.astype(jnp.float32) @ w_router.astype(jnp.float32))
    biased = scores + bias.astype(jnp.float32)
    grp_score = lax.top_k(biased.reshape(N, N_GROUPS, per_group), 2)[0].sum(-1)
    _, gidx = lax.top_k(grp_score, TOPK_GROUPS)
    gmask = jax.nn.one_hot(gidx, N_GROUPS, dtype=jnp.float32).sum(axis=1) > 0
    emask = jnp.repeat(gmask, per_group, axis=1)
    _, idx = lax.top_k(jnp.where(emask, biased, -jnp.inf), TOP_K)
    wts = jnp.take_along_axis(scores, idx, axis=1)
    wts = wts / jnp.sum(wts, axis=-1, keepdims=True) * ROUTED_SCALE
    return idx, wts


def routed_experts(xf, idx, wts, w1, w3, w2):
    N, D = xf.shape
    M = N * TOP_K
    flat_e = idx.reshape(-1)
    flat_tok = jnp.arange(M, dtype=jnp.int32) // TOP_K
    flat_w = wts.reshape(-1)
    order = jnp.argsort(flat_e)
    e_s, tok_s, w_s = flat_e[order], flat_tok[order], flat_w[order]
    counts = jnp.bincount(flat_e, length=N_EXPERTS)
    padded = (counts + MOE_BLOCK - 1) // MOE_BLOCK * MOE_BLOCK
    pend = jnp.cumsum(padded)
    pstart = pend - padded
    gstart = jnp.cumsum(counts) - counts
    dest = pstart[e_s] + (jnp.arange(M) - gstart[e_s])
    n_blocks = (M + MOE_BLOCK - 1) // MOE_BLOCK + N_EXPERTS
    P = n_blocks * MOE_BLOCK
    slot_tok = jnp.full((P,), N, dtype=jnp.int32).at[dest].set(tok_s)
    slot_w = jnp.zeros((P,), jnp.float32).at[dest].set(w_s)
    block_e = jnp.clip(jnp.searchsorted(pend, jnp.arange(n_blocks) * MOE_BLOCK, side='right'),
                       0, N_EXPERTS - 1)
    xpad = jnp.concatenate([xf, jnp.zeros((1, D), xf.dtype)], axis=0)

    def body(acc, blk):
        tok_b, w_b, e = blk
        xb = xpad[tok_b]
        hb = jax.nn.silu(xb @ w1[e]) * (xb @ w3[e])
        yb = (hb @ w2[e]).astype(jnp.float32) * w_b[:, None]
        return acc.at[tok_b].add(yb), None

    acc, _ = lax.scan(body, jnp.zeros((N + 1, D), jnp.float32),
                      (slot_tok.reshape(n_blocks, MOE_BLOCK), slot_w.reshape(n_blocks, MOE_BLOCK), block_e))
    return acc[:N]


def moe_ffn(h, w_router, bias, w1, w3, w2, s1, s3, s2):
    B, S, D = h.shape
    xf = h.reshape(B * S, D)
    idx, wts = route(xf, w_router, bias)
    routed = routed_experts(xf, idx, wts, w1, w3, w2)
    shared = (jax.nn.silu(xf @ s1) * (xf @ s3)) @ s2
    return (shared.astype(jnp.float32) + routed).astype(h.dtype).reshape(B, S, D)


def setup_inputs(seed: int = 0) -> dict:
    key = jax.random.key(seed)
    ks = jax.random.split(key, 26)
    f32 = jnp.float32
    D = D_MODEL
    nrm = lambda k, shape, fan: jax.random.normal(k, shape, f32) * (fan ** -0.5)
    rnd = lambda k, shape, s: s * jax.random.normal(k, shape, f32)
    return {
        "x": jax.random.normal(ks[0], (BATCH, SEQ, D), f32),
        "c": jax.random.normal(ks[1], (BATCH, D), f32),
        "ada_w": rnd(ks[2], (DEPTH, D, 6 * D), 0.01),
        "ada_b": rnd(ks[3], (DEPTH, 6 * D), 0.02),
        "norm1_g": 1.0 + rnd(ks[4], (DEPTH, D), 0.05),
        "norm2_g": 1.0 + rnd(ks[5], (DEPTH, D), 0.05),
        "ev_w_in": nrm(ks[6], (N_EVEN, D, EVEN_IN), D),
        "ev_dw_w": nrm(ks[7], (N_EVEN, CONV_KERNEL, 1, CONV_WIDTH), CONV_KERNEL),
        "ev_dw_b": rnd(ks[8], (N_EVEN, CONV_WIDTH), 0.02),
        "ev_ln_g": 1.0 + rnd(ks[9], (N_EVEN, CONV_WIDTH), 0.05),
        "ev_ln_b": rnd(ks[10], (N_EVEN, CONV_WIDTH), 0.02),
        "ev_w_out": nrm(ks[11], (N_EVEN, EVEN_MIX, D), EVEN_MIX),
        "od_w_in": nrm(ks[12], (N_ODD, D, D), D),
        "od_w_grp": nrm(ks[13], (N_ODD, len(POOL_WINDOWS), POOL_GROUP, POOL_GROUP), POOL_GROUP),
        "od_scale": 1.0 + rnd(ks[14], (N_ODD, D), 0.1),
        "od_w_out": nrm(ks[15], (N_ODD, D, D), D),
        "moe_w_router": nrm(ks[16], (DEPTH, D, N_EXPERTS), D),
        "moe_bias": rnd(ks[17], (DEPTH, N_EXPERTS), 0.01),
        "moe_w1": nrm(ks[18], (DEPTH, N_EXPERTS, D, EXPERT_FF), D),
        "moe_w3": nrm(ks[19], (DEPTH, N_EXPERTS, D, EXPERT_FF), D),
        "moe_w2": nrm(ks[20], (DEPTH, N_EXPERTS, EXPERT_FF, D), EXPERT_FF),
        "sh_w1": nrm(ks[21], (DEPTH, D, SHARED_FF), D),
        "sh_w3": nrm(ks[22], (DEPTH, D, SHARED_FF), D),
        "sh_w2": nrm(ks[23], (DEPTH, SHARED_FF, D), SHARED_FF),
        "final_g": 1.0 + rnd(ks[24], (D,), 0.05),
    }


def reference(x, c, ada_w, ada_b, norm1_g, norm2_g, ev_w_in, ev_dw_w, ev_dw_b, ev_ln_g, ev_ln_b,
              ev_w_out, od_w_in, od_w_grp, od_scale, od_w_out, moe_w_router, moe_bias, moe_w1,
              moe_w3, moe_w2, sh_w1, sh_w3, sh_w2, final_g):
    cond = jax.nn.silu(c)
    for l in range(DEPTH):
        mod = cond @ ada_w[l] + ada_b[l]
        sh1, sc1, g1, sh2, sc2, g2 = [m[:, None, :] for m in jnp.split(mod, 6, axis=-1)]
        h = modulate(rmsnorm(x, norm1_g[l]), sh1, sc1)
        i = l // 2
        if l % 2 == 0:
            y = even_mixer(h, ev_w_in[i], ev_dw_w[i], ev_dw_b[i], ev_ln_g[i], ev_ln_b[i], ev_w_out[i])
        else:
            y = odd_mixer(h, od_w_in[i], od_w_grp[i], od_scale[i], od_w_out[i])
        x = x + g1 * y
        h = modulate(rmsnorm(x, norm2_g[l]), sh2, sc2)
        x = x + g2 * moe_ffn(h, moe_w_router[l], moe_bias[l], moe_w1[l], moe_w3[l], moe_w2[l],
                             sh_w1[l], sh_w3[l], sh_w2[l])
    return rmsnorm(x, final_g)
```

```cpp
#include <hip/hip_runtime.h>
#include <cstdio>
#include <cstdint>

#ifndef MK_PER_PHASE
#define MK_PER_PHASE 0
#endif

#define LAS __attribute__((address_space(3)))
#define GAS __attribute__((address_space(1)))
typedef unsigned short bf16;
typedef short bf16x8 __attribute__((ext_vector_type(8)));
typedef float f32x2 __attribute__((ext_vector_type(2)));
typedef float f32x4 __attribute__((ext_vector_type(4)));
typedef float f32x16 __attribute__((ext_vector_type(16)));
typedef unsigned u32x2 __attribute__((ext_vector_type(2)));
typedef unsigned u32x4 __attribute__((ext_vector_type(4)));
typedef __bf16 bf16x2_t __attribute__((ext_vector_type(2)));
typedef GAS unsigned gu32;

#define LDS_WAIT() asm volatile("s_waitcnt lgkmcnt(0)" ::: "memory")
#define VM_WAIT() asm volatile("s_waitcnt vmcnt(0)" ::: "memory")
#define RLX_AGENT __ATOMIC_RELAXED, __HIP_MEMORY_SCOPE_AGENT

__device__ __forceinline__ unsigned pk2(float lo, float hi) { f32x2 v = {lo, hi}; bf16x2_t b = __builtin_convertvector(v, bf16x2_t); return __builtin_bit_cast(unsigned, b); }
__device__ __forceinline__ float bflo(unsigned u) { return __builtin_bit_cast(float, u << 16); }
__device__ __forceinline__ float bfhi(unsigned u) { return __builtin_bit_cast(float, u & 0xffff0000u); }
__device__ __forceinline__ float fexp2(float x) { return __builtin_amdgcn_exp2f(x); }
__device__ __forceinline__ float frcp(float x) { return __builtin_amdgcn_rcpf(x); }
__device__ __forceinline__ float sigmoidf_(float x) { return frcp(1.f + fexp2(-1.44269504f * x)); }
__device__ __forceinline__ float wave_sum(float v) {
#define WS_DPP(ctrl) v += __builtin_bit_cast(float, __builtin_amdgcn_update_dpp(0, __builtin_bit_cast(int, v), (ctrl), 0xf, 0xf, false))
    WS_DPP(0xB1); WS_DPP(0x4E); WS_DPP(0x141); WS_DPP(0x140);
#undef WS_DPP
    const int vi = __builtin_bit_cast(int, v);
    v = (__builtin_bit_cast(float, __builtin_amdgcn_readlane(vi, 0)) + __builtin_bit_cast(float, __builtin_amdgcn_readlane(vi, 16)))
      + (__builtin_bit_cast(float, __builtin_amdgcn_readlane(vi, 32)) + __builtin_bit_cast(float, __builtin_amdgcn_readlane(vi, 48)));
    return v;
}

namespace pg8 {
constexpr int BM = 256, BK = 64, HALF = 128, HTB = HALF * BK * 2, STAGE_BYTES = 8 * HTB, NXCD = 8, WGM = 8;
typedef int v4i __attribute__((ext_vector_type(4)));
typedef int v8i __attribute__((ext_vector_type(8)));
constexpr int FP8_SHIFT_G1 = 10, FP8_SCALE_G1 = 0x7A7A7A7A;
constexpr int FP8_SHIFT_G2 = 8, FP8_SCALE_G2 = 0x7B7B7B7B;
constexpr int FP8_UNUSED_ = 0;
__host__ __device__ __forceinline__ int lds_byte(int r, int c) { const int st = (r >> 4) * 2 + (c >> 5), rr = r & 15, cc = c & 31, ob = rr * 64 + cc * 2; return st * 1024 + (ob ^ (((ob >> 9) & 1) << 5)); }
__host__ __device__ __forceinline__ void stage_rc(int b, int& R, int& C) { const int st = b / 1024, sb = b % 1024, swz = sb ^ (((sb >> 9) & 1) << 5); R = (st >> 1) * 16 + swz / 64; C = (st & 1) * 32 + (swz % 64) / 2; }
__host__ __device__ __forceinline__ int perm32(int rho) { const int n = rho >> 4, i = rho & 15; return 8 * (i >> 2) + 4 * n + (i & 3); }

struct Unit { const char* pa; const char* pb; const int* list; int row0; int orow; int nvalid; int pn; int og; };

struct StaticMN {
    int nM, nN, nwg, G, c;
    __device__ void init(int M, int N, int G_, int c_) { nM = M / BM; nN = N / BM; nwg = nM * nN; G = G_; c = c_; }
    __device__ bool next(int i, int& pm, int& pn) const {
        const long L = (long)i * G + c; if (L >= nwg) return false;
        int wgid = (int)L; { const int q = nwg / NXCD, r = nwg % NXCD, xcd = wgid % NXCD, off = wgid / NXCD; wgid = (xcd < r ? xcd * (q + 1) : r * (q + 1) + (xcd - r) * q) + off; }
        const int nig = WGM * nN, gid = wgid / nig, fm = gid * WGM, gsz = (nM - fm) < WGM ? (nM - fm) : WGM;
        pm = fm + ((wgid % nig) % gsz); pn = (wgid % nig) / gsz; return true;
    }
};

__device__ __forceinline__ void glds16s(const char* base, unsigned voff, unsigned lds_dst) { unsigned keep;
    asm volatile("s_mov_b32 %0, m0\n\ts_mov_b32 m0, %2\n\ts_nop 0\n\tglobal_load_lds_dwordx4 %1, %3\n\ts_mov_b32 m0, %0" : "=&s"(keep) : "v"(voff), "s"(lds_dst), "s"(base) : "memory"); }
template <class Epi, class Sched, bool GATHER, bool FP8 = false, int FP8_SCALE = 0x7F7F7F7F, bool ALIGN = true>
__device__ __forceinline__ void gemm_phase(LAS unsigned char* lds, const int Kb  , const Sched& S, const Epi& E) {
    int tid; asm volatile("v_mov_b32 %0, %1" : "=v"(tid) : "v"((int)threadIdx.x));
    const int wid = __builtin_amdgcn_readfirstlane(tid >> 6), lane = tid & 63, wr = wid >> 2, wc = wid & 3, fr = lane & 15, fq = lane >> 4;
    const int nt = Kb / 128;
    unsigned voffB[2];
#pragma unroll
    for (int i = 0; i < 2; ++i) { int R, C; stage_rc(tid * 16 + i * 8192, R, C); const int Rb = Epi::NCONT ? ((R >> 5) * 64 + perm32(R & 31)) : ((R & ~31) + perm32(R & 31));
        voffB[i] = (unsigned)(Rb * Kb + C * 2); }
    const size_t kstep = (size_t)(BK * 2);
    const size_t hstep = (size_t)(Epi::NCONT ? 32 : HALF) * Kb;
    const unsigned ldsb = (unsigned)__builtin_amdgcn_readfirstlane((int)((unsigned)(__UINTPTR_TYPE__)lds + (unsigned)wid * 1024u));
    const int aoff = lds_byte(wr * 64 + fr, fq * 8), boff = lds_byte(wc * 32 + fr, fq * 8);
#define PG8_SA(b, h) (((b) * 2 + (h)) * HTB)
#define PG8_SB(b, h) ((4 + (b) * 2 + (h)) * HTB)
#define PG8_STAGE_B(bufoff, gbase) do { _Pragma("unroll") for (int _i = 0; _i < 2; ++_i) glds16s((const char*)(gbase), voffB[_i], ldsb + (unsigned)((bufoff) + _i * 8192)); } while (0)
#define PG8_STAGE_A(bufoff, gbase, vv, h) do { _Pragma("unroll") for (int _i = 0; _i < 2; ++_i) glds16s((const char*)(gbase), (vv)[h][_i], ldsb + (unsigned)((bufoff) + _i * 8192)); } while (0)
#define PG8_ROWOFF(u, v) do { _Pragma("unroll") for (int _h = 0; _h < 2; ++_h) _Pragma("unroll") for (int _i = 0; _i < 2; ++_i) { int _R, _C; stage_rc(tid * 16 + _i * 8192, _R, _C); const int _r = _h * HALF + _R; int _t; \
        if (GATHER) { if ((u).list) _t = (u).list[_r < (u).nvalid ? _r : 0]; else _t = (u).row0 + _r; } else _t = _r; \
        (v)[_h][_i] = (unsigned)_t * (unsigned)Kb + (unsigned)_C * 2u; } } while (0)
#define PG8_ROWTOK(u, tk) do { _Pragma("unroll") for (int _h = 0; _h < 2; ++_h) _Pragma("unroll") for (int _i = 0; _i < 2; ++_i) { int _R, _C; stage_rc(tid * 16 + _i * 8192, _R, _C); const int _r = _h * HALF + _R; \
        if ((u).list) (tk)[_h][_i] = (unsigned)(u).list[_r < (u).nvalid ? _r : 0]; else (tk)[_h][_i] = (unsigned)((u).row0 + _r); } } while (0)
#define PG8_TOK2OFF(tk, v) do { _Pragma("unroll") for (int _h = 0; _h < 2; ++_h) _Pragma("unroll") for (int _i = 0; _i < 2; ++_i) { int _R, _C; stage_rc(tid * 16 + _i * 8192, _R, _C); \
        (v)[_h][_i] = (unsigned)(tk)[_h][_i] * (unsigned)Kb + (unsigned)_C * 2u; } } while (0)
#define PG8_LDA(dst, b, h) do { _Pragma("unroll") for (int m = 0; m < 4; ++m) _Pragma("unroll") for (int k = 0; k < 2; ++k) dst[m][k] = *(const LAS bf16x8*)(lds + PG8_SA(b, h) + aoff + m * 2048 + k * 1024); } while (0)
#define PG8_LDB(dst, b, h) do { _Pragma("unroll") for (int n = 0; n < 2; ++n) _Pragma("unroll") for (int k = 0; k < 2; ++k) dst[n][k] = *(const LAS bf16x8*)(lds + PG8_SB(b, h) + boff + n * 2048 + k * 1024); } while (0)
#define PG8_CAT(x0, x1) __builtin_shufflevector(__builtin_bit_cast(v4i, x0), __builtin_bit_cast(v4i, x1), 0, 1, 2, 3, 4, 5, 6, 7)
#define PG8_MMA(ai, bj, At, Bt, zc) do { __builtin_amdgcn_s_setprio(1); \
        if (FP8) { const v8i b8_0 = PG8_CAT(Bt[0][0], Bt[0][1]), b8_1 = PG8_CAT(Bt[1][0], Bt[1][1]); \
            if (zc) {     \
              _Pragma("unroll") for (int m = 0; m < 4; ++m) { const v8i a8 = PG8_CAT(At[m][0], At[m][1]); \
                asm volatile("v_mfma_scale_f32_16x16x128_f8f6f4 %0, %1, %2, 0, %3, %4 op_sel_hi:[0,0,0]" : "=&v"(acc[ai][bj][m][0]) : "v"(b8_0), "v"(a8), "v"(scw), "v"(scw)); \
                asm volatile("v_mfma_scale_f32_16x16x128_f8f6f4 %0, %1, %2, 0, %3, %4 op_sel_hi:[0,0,0]" : "=&v"(acc[ai][bj][m][1]) : "v"(b8_1), "v"(a8), "v"(scw), "v"(scw)); } } \
            else { \
              _Pragma("unroll") for (int m = 0; m < 4; ++m) { const v8i a8 = PG8_CAT(At[m][0], At[m][1]); \
                asm volatile("v_mfma_scale_f32_16x16x128_f8f6f4 %0, %1, %2, %0, %3, %4 op_sel_hi:[0,0,0]" : "+v"(acc[ai][bj][m][0]) : "v"(b8_0), "v"(a8), "v"(scw), "v"(scw)); \
                asm volatile("v_mfma_scale_f32_16x16x128_f8f6f4 %0, %1, %2, %0, %3, %4 op_sel_hi:[0,0,0]" : "+v"(acc[ai][bj][m][1]) : "v"(b8_1), "v"(a8), "v"(scw), "v"(scw)); } } } \
        else { _Pragma("unroll") for (int m = 0; m < 4; ++m) _Pragma("unroll") for (int n = 0; n < 2; ++n) _Pragma("unroll") for (int k = 0; k < 2; ++k) \
            acc[ai][bj][m][n] = __builtin_amdgcn_mfma_f32_16x16x32_bf16(Bt[n][k], At[m][k], acc[ai][bj][m][n], 0, 0, 0); } __builtin_amdgcn_s_setprio(0); } while (0)
#define PG8_WAIT_V(n) asm volatile("s_waitcnt vmcnt(" #n ")" ::: "memory")
#define PG8_WAIT_L(n) asm volatile("s_waitcnt lgkmcnt(" #n ")" ::: "memory")
#define PG8_BAR __builtin_amdgcn_s_barrier()
#define PG8_SCHED __builtin_amdgcn_sched_barrier(0)
    Unit cur, nxt; int ui = 0;
    if (!S.next(0, cur)) return;
    f32x4 acc[2][2][4][2];
#pragma unroll
    for (int a = 0; a < 2; ++a)
#pragma unroll
        for (int b = 0; b < 2; ++b)
#pragma unroll
            for (int m = 0; m < 4; ++m)
#pragma unroll
                for (int n = 0; n < 2; ++n) acc[a][b][m][n] = (f32x4){0.f, 0.f, 0.f, 0.f};
    bf16x8 At[4][2], B0[2][2], B1[2][2];
    const int scw = FP8_SCALE;
    unsigned vA[2][2], vN[2][2];
    PG8_ROWOFF(cur, vA);
    const char* cA = cur.pa; const char* cB = cur.pb;
    PG8_STAGE_B(PG8_SB(0, 0), cB); PG8_STAGE_B(PG8_SB(0, 1), cB + hstep); PG8_STAGE_A(PG8_SA(0, 0), cA, vA, 0); PG8_STAGE_A(PG8_SA(0, 1), cA, vA, 1);
    if (wr == 1) PG8_BAR;
    PG8_WAIT_V(2); PG8_BAR;
    PG8_STAGE_B(PG8_SB(1, 0), cB + kstep); PG8_STAGE_A(PG8_SA(1, 0), cA + kstep, vA, 0); PG8_STAGE_B(PG8_SB(1, 1), cB + hstep + kstep);
    PG8_WAIT_V(6); PG8_BAR;
    for (;;) {
        const bool has_next = S.next(ui + 1, nxt);
        const char* nA = has_next ? nxt.pa : cA; const char* nB = has_next ? nxt.pb : cB;
        if (GATHER && has_next) { PG8_ROWTOK(nxt, vN); }
        else {
#pragma unroll
            for (int h = 0; h < 2; ++h)
#pragma unroll
                for (int i = 0; i < 2; ++i) vN[h][i] = vA[h][i]; }
#define PG8_TRIP(a1, a2, b2, w2, zc) do { const char* a3 = (a2) + kstep; const char* b3 = (b2) + kstep; \
              \
            PG8_LDB(B0, 0, 0); PG8_LDB(B1, 0, 1); PG8_SCHED; PG8_LDA(At, 0, 0); PG8_STAGE_A(PG8_SA(1, 1), a1, vA, 1); \
            PG8_WAIT_V(8); PG8_WAIT_L(0); PG8_BAR; PG8_MMA(0, 0, At, B0, zc); PG8_MMA(0, 1, At, B1, zc); PG8_BAR; PG8_SCHED; \
              \
            PG8_LDA(At, 0, 1); PG8_STAGE_B(PG8_SB(0, 0), b2); PG8_STAGE_B(PG8_SB(0, 1), (b2) + hstep); PG8_STAGE_A(PG8_SA(0, 0), a2, w2, 0); \
            PG8_WAIT_V(8); PG8_WAIT_L(0); PG8_BAR; PG8_MMA(1, 0, At, B0, zc); PG8_MMA(1, 1, At, B1, zc); PG8_BAR; PG8_SCHED; \
              \
            PG8_LDB(B0, 1, 0); PG8_LDB(B1, 1, 1); PG8_SCHED; PG8_LDA(At, 1, 0); PG8_STAGE_A(PG8_SA(0, 1), a2, w2, 1); \
            PG8_WAIT_V(8); PG8_WAIT_L(0); PG8_BAR; PG8_MMA(0, 0, At, B0, false); PG8_MMA(0, 1, At, B1, false); PG8_BAR; PG8_SCHED; \
              \
            PG8_LDA(At, 1, 1); PG8_STAGE_B(PG8_SB(1, 0), b3); PG8_STAGE_B(PG8_SB(1, 1), b3 + hstep); PG8_STAGE_A(PG8_SA(1, 0), a3, w2, 0); \
            PG8_WAIT_V(8); PG8_WAIT_L(0); PG8_BAR; PG8_MMA(1, 0, At, B0, false); PG8_MMA(1, 1, At, B1, false); PG8_BAR; PG8_SCHED; } while (0)
        if (GATHER) {
#pragma unroll 1
            for (int t = 0; t < nt - 2; t += 2) { const char* a1 = cA + (size_t)(t + 1) * kstep; const char* a2 = cA + (size_t)(t + 2) * kstep; const char* b2 = cB + (size_t)(t + 2) * kstep; const bool zc = FP8 && t == 0; PG8_TRIP(a1, a2, b2, vA, zc); }
            { const char* a1 = cA + (size_t)(nt - 1) * kstep;
              if (has_next) { PG8_TOK2OFF(vN, vN); }
              const bool zc = FP8 && nt == 2; PG8_TRIP(a1, nA, nB, vN, zc); }
        } else {
#pragma unroll 1
            for (int t = 0; t < nt; t += 2) { const bool last = (t == nt - 2); const char* a1 = cA + (size_t)(t + 1) * kstep;
                const char* a2 = last ? nA : cA + (size_t)(t + 2) * kstep; const char* b2 = last ? nB : cB + (size_t)(t + 2) * kstep; const bool zc = FP8 && t == 0; PG8_TRIP(a1, a2, b2, vA, zc); }
        }
#undef PG8_TRIP
        if (ALIGN && wr == 0) PG8_BAR;
        if (FP8) { asm volatile("s_nop 15\n\ts_nop 15" ::: "memory");
#pragma unroll
            for (int a_ = 0; a_ < 2; ++a_)
#pragma unroll
                for (int b_ = 0; b_ < 2; ++b_) asm volatile("" : "+v"(acc[a_][b_][0][0]), "+v"(acc[a_][b_][0][1]), "+v"(acc[a_][b_][1][0]), "+v"(acc[a_][b_][1][1]), "+v"(acc[a_][b_][2][0]), "+v"(acc[a_][b_][2][1]), "+v"(acc[a_][b_][3][0]), "+v"(acc[a_][b_][3][1])); }
        E(acc, cur, wr, wc, fr, fq);
        if (!has_next) break;
        if (!FP8)
#pragma unroll
        for (int a = 0; a < 2; ++a)
#pragma unroll
            for (int b = 0; b < 2; ++b)
#pragma unroll
                for (int m = 0; m < 4; ++m)
#pragma unroll
                    for (int n = 0; n < 2; ++n) acc[a][b][m][n] = (f32x4){0.f, 0.f, 0.f, 0.f};
        cur = nxt; cA = nA; cB = nB; ++ui;
#pragma unroll
        for (int h = 0; h < 2; ++h)
#pragma unroll
            for (int i = 0; i < 2; ++i) vA[h][i] = vN[h][i];
        if (ALIGN && wr == 1) PG8_BAR;
    }
    if (!ALIGN && wr == 0) PG8_BAR;
    PG8_WAIT_V(0);
    PG8_BAR;
#undef PG8_SA
#undef PG8_SB
#undef PG8_STAGE_A
#undef PG8_STAGE_B
#undef PG8_ROWOFF
#undef PG8_ROWTOK
#undef PG8_TOK2OFF
#undef PG8_LDA
#undef PG8_LDB
#undef PG8_MMA
#undef PG8_CAT
#undef PG8_WAIT_V
#undef PG8_WAIT_L
#undef PG8_BAR
#undef PG8_SCHED
}

__device__ __forceinline__ int xor16(int v, bool odd) { const auto sw = __builtin_amdgcn_permlane16_swap((unsigned)v, (unsigned)v, false, false); return (int)(odd ? sw[0] : sw[1]); }
__device__ __forceinline__ u32x4 pack8(const f32x4& v0, const f32x4& v1) { u32x4 w; w.x = pk2(v0[0], v0[1]); w.y = pk2(v0[2], v0[3]); w.z = pk2(v1[0], v1[1]); w.w = pk2(v1[2], v1[3]); return w; }

struct EpiStore {
    static constexpr bool NCONT = true;
    bf16* O0; int ld0; bf16* O1; int ld1;
    __device__ __forceinline__ void operator()(const f32x4 (&acc)[2][2][4][2], const Unit& u, int wr, int wc, int fr, int fq) const {
        char* Ob = (char*)(u.og ? O1 : O0); const unsigned ldb = (unsigned)(u.og ? ld1 : ld0) * 2u;
        const unsigned cb = (unsigned)(u.pn * BM + wc * 64 + 8 * fq) * 2u; const int rl0 = wr * 64 + fr;
#pragma unroll
        for (int ai = 0; ai < 2; ++ai)
#pragma unroll
            for (int m = 0; m < 4; ++m) { const int rl = rl0 + ai * HALF + m * 16;
                if (rl < u.nvalid) { const unsigned off = (unsigned)(u.orow + rl) * ldb + cb;
#pragma unroll
                    for (int bj = 0; bj < 2; ++bj) *(u32x4*)(Ob + off + bj * 64) = pack8(acc[ai][bj][m][0], acc[ai][bj][m][1]); } }
    }
};
struct EpiResid {
    static constexpr bool NCONT = true;
    bf16* X; const float* g1;
    __device__ __forceinline__ void operator()(const f32x4 (&acc)[2][2][4][2], const Unit& u, int wr, int wc, int fr, int fq) const {
        char* Xb = (char*)X; const int col0 = u.pn * BM + wc * 64 + 8 * fq; const int rl0 = wr * 64 + fr; const float* gp = g1 + (size_t)(u.orow >> 12) * 6144 + col0;
        f32x4 g[2][2];
#pragma unroll
        for (int bj = 0; bj < 2; ++bj) { g[bj][0] = *(const f32x4*)(gp + bj * 32); g[bj][1] = *(const f32x4*)(gp + bj * 32 + 4); }
#pragma unroll
        for (int ai = 0; ai < 2; ++ai) {
            u32x4 xr[4][2];
#pragma unroll
            for (int m = 0; m < 4; ++m)
#pragma unroll
                for (int bj = 0; bj < 2; ++bj) xr[m][bj] = *(const u32x4*)(Xb + (unsigned)(u.orow + rl0 + ai * HALF + m * 16) * 2048u + (unsigned)(col0 + bj * 32) * 2u);
#pragma unroll
            for (int m = 0; m < 4; ++m)
#pragma unroll
                for (int bj = 0; bj < 2; ++bj) { const u32x4 x = xr[m][bj]; const f32x4 a0 = acc[ai][bj][m][0], a1 = acc[ai][bj][m][1]; f32x4 v0, v1;
                    v0[0] = bflo(x.x) + g[bj][0][0] * a0[0]; v0[1] = bfhi(x.x) + g[bj][0][1] * a0[1]; v0[2] = bflo(x.y) + g[bj][0][2] * a0[2]; v0[3] = bfhi(x.y) + g[bj][0][3] * a0[3];
                    v1[0] = bflo(x.z) + g[bj][1][0] * a1[0]; v1[1] = bfhi(x.z) + g[bj][1][1] * a1[1]; v1[2] = bflo(x.w) + g[bj][1][2] * a1[2]; v1[3] = bfhi(x.w) + g[bj][1][3] * a1[3];
                    *(u32x4*)(Xb + (unsigned)(u.orow + rl0 + ai * HALF + m * 16) * 2048u + (unsigned)(col0 + bj * 32) * 2u) = pack8(v0, v1); }
            __builtin_amdgcn_sched_barrier(0); }
    }
};
struct EpiPair {
    static constexpr bool NCONT = true;
    unsigned char* PAIR; unsigned char* SOUT8;
    __device__ __forceinline__ void operator()(const f32x4 (&acc)[2][2][4][2], const Unit& u, int wr, int wc, int fr, int fq) const {
        const int rl0 = wr * 64 + fr; unsigned char* Ob = u.og ? SOUT8 : PAIR;
        { const bool odd = fq & 1;
            const unsigned cb16 = (unsigned)(u.pn * BM + wc * 64 + 8 * (fq & ~1) + (odd ? 32 : 0));
#pragma unroll
            for (int ai = 0; ai < 2; ++ai)
#pragma unroll
                for (int m = 0; m < 4; ++m) { const int rl = rl0 + ai * HALF + m * 16; int t[2][2];
#pragma unroll
                    for (int bj = 0; bj < 2; ++bj) { const f32x4 v0 = acc[ai][bj][m][0], v1 = acc[ai][bj][m][1];
                        int t0 = __builtin_amdgcn_cvt_pk_fp8_f32(v0[0], v0[1], 0, false); t0 = __builtin_amdgcn_cvt_pk_fp8_f32(v0[2], v0[3], t0, true);
                        int t1 = __builtin_amdgcn_cvt_pk_fp8_f32(v1[0], v1[1], 0, false); t1 = __builtin_amdgcn_cvt_pk_fp8_f32(v1[2], v1[3], t1, true); t[bj][0] = t0; t[bj][1] = t1; }
                    const int r0 = xor16(odd ? t[0][0] : t[1][0], odd), r1 = xor16(odd ? t[0][1] : t[1][1], odd);
                    u32x4 w; if (odd) { w.x = (unsigned)r0; w.y = (unsigned)r1; w.z = (unsigned)t[1][0]; w.w = (unsigned)t[1][1]; } else { w.x = (unsigned)t[0][0]; w.y = (unsigned)t[0][1]; w.z = (unsigned)r0; w.w = (unsigned)r1; }
                    if (rl < u.nvalid) *(u32x4*)(Ob + (unsigned)(u.orow + rl) * 1024u + cb16) = w; }
        }
    }
};
struct EpiEven {      static constexpr bool NCONT = true;
    bf16* QKV; bf16* U;
    __device__ __forceinline__ void operator()(const f32x4 (&acc)[2][2][4][2], const Unit& u, int wr, int wc, int fr, int fq) const {
        const int rl0 = wr * 64 + fr;
        if (u.pn < 6) { const float sc = u.pn < 2 ? 0.125f : 1.f; char* Ob = (char*)QKV; const unsigned cb = (unsigned)(u.pn * BM + wc * 64 + 8 * fq) * 2u;
#pragma unroll
            for (int ai = 0; ai < 2; ++ai)
#pragma unroll
                for (int m = 0; m < 4; ++m) { const unsigned off = (unsigned)(u.orow + rl0 + ai * HALF + m * 16) * 3072u + cb;
#pragma unroll
                    for (int bj = 0; bj < 2; ++bj) { f32x4 v0 = acc[ai][bj][m][0] * sc, v1 = acc[ai][bj][m][1] * sc; *(u32x4*)(Ob + off + bj * 64) = pack8(v0, v1); } }
        } else { char* Ob = (char*)U; const unsigned cb = (unsigned)((u.pn - 6) * HALF + wc * 32 + 8 * fq) * 2u;
#pragma unroll
            for (int ai = 0; ai < 2; ++ai)
#pragma unroll
                for (int m = 0; m < 4; ++m) { f32x4 v0, v1;
#pragma unroll
                    for (int e = 0; e < 4; ++e) { v0[e] = acc[ai][0][m][0][e] * sigmoidf_(acc[ai][1][m][0][e]); v1[e] = acc[ai][0][m][1][e] * sigmoidf_(acc[ai][1][m][1][e]); }
                    *(u32x4*)(Ob + (unsigned)(u.orow + rl0 + ai * HALF + m * 16) * 1024u + cb) = pack8(v0, v1); }
        }
    }
};
struct EpiSwiGLU {    static constexpr bool NCONT = false;
    unsigned char* HR; unsigned char* HS;
    __device__ __forceinline__ void operator()(const f32x4 (&acc)[2][2][4][2], const Unit& u, int wr, int wc, int fr, int fq) const {
        unsigned char* Ob = u.og ? HS : HR; const bool odd = fq & 1; const unsigned cb = (unsigned)(u.pn * HALF + wc * 32 + 8 * (fq & ~1)); const int rl0 = wr * 64 + fr;
#pragma unroll
        for (int ai = 0; ai < 2; ++ai)
#pragma unroll
            for (int mp = 0; mp < 2; ++mp) { int t[2][2];
#pragma unroll
                for (int mm = 0; mm < 2; ++mm) { const int m = 2 * mp + mm; f32x4 v0, v1;
#pragma unroll
                    for (int e = 0; e < 4; ++e) { const float a0 = acc[ai][0][m][0][e], a1 = acc[ai][0][m][1][e];
                        v0[e] = a0 * sigmoidf_(a0) * acc[ai][1][m][0][e]; v1[e] = a1 * sigmoidf_(a1) * acc[ai][1][m][1][e]; }
                    int t0 = __builtin_amdgcn_cvt_pk_fp8_f32(v0[0], v0[1], 0, false); t0 = __builtin_amdgcn_cvt_pk_fp8_f32(v0[2], v0[3], t0, true);
                    int t1 = __builtin_amdgcn_cvt_pk_fp8_f32(v1[0], v1[1], 0, false); t1 = __builtin_amdgcn_cvt_pk_fp8_f32(v1[2], v1[3], t1, true); t[mm][0] = t0; t[mm][1] = t1; }
                const int r0 = xor16(odd ? t[0][0] : t[1][0], odd), r1 = xor16(odd ? t[0][1] : t[1][1], odd);
                u32x4 w; if (odd) { w.x = (unsigned)r0; w.y = (unsigned)r1; w.z = (unsigned)t[1][0]; w.w = (unsigned)t[1][1]; } else { w.x = (unsigned)t[0][0]; w.y = (unsigned)t[0][1]; w.z = (unsigned)r0; w.w = (unsigned)r1; }
                const int rl = rl0 + ai * HALF + (2 * mp + (odd ? 1 : 0)) * 16;
                if (rl < u.nvalid) *(u32x4*)(Ob + (unsigned)(u.orow + rl) * 256u + cb) = w; }
    }
};

struct DenseSched {
    const char* A; const char* Bt; int Kb; StaticMN so;
    __device__ __forceinline__ bool next(int i, Unit& u) const { int pm, pn; if (!so.next(i, pm, pn)) return false;
        u.pa = A + (size_t)pm * BM * Kb; u.pb = Bt + (size_t)pn * BM * Kb; u.list = nullptr; u.row0 = pm * BM; u.orow = pm * BM; u.nvalid = BM; u.pn = pn; u.og = 0; return true; }
};
struct MoeSched {
    const LAS int* tab; int T, nsplit, nshared, G, c, Kb, gemm1;
    const char* Ash; const char* Art; const char* Bsh; const char* Brt; size_t bstride_e, bstride_n; const int* tokof;
    __device__ __forceinline__ bool next(int i, Unit& u) const {
        const int L = i * G + c; if (L >= nshared + T * nsplit) return false;
        if (L < nshared) { const int mt = L / nsplit, pn = L % nsplit; u.og = 1; u.orow = mt * BM; u.row0 = mt * BM; u.nvalid = BM; u.list = nullptr; u.pn = pn;
            u.pb = Bsh + (size_t)pn * bstride_n; u.pa = gemm1 ? Ash : Ash + (size_t)mt * BM * Kb; return true; }
        const int Lr = L - nshared, mt = Lr / nsplit, pn = Lr % nsplit;
        const int lo = (int)((const LAS unsigned short*)(tab + 512))[mt];
        const int e = __builtin_amdgcn_readfirstlane(lo), j = mt - __builtin_amdgcn_readfirstlane(tab[e]), ne = __builtin_amdgcn_readfirstlane(tab[160 + e]), cs = __builtin_amdgcn_readfirstlane(tab[80 + e]);
        const int nv = ne - j * BM; u.nvalid = nv < BM ? nv : BM; u.orow = cs + j * BM; u.row0 = 0; u.og = 0; u.pn = pn; u.pb = Brt + (size_t)e * bstride_e + (size_t)pn * bstride_n;
        if (gemm1) { u.list = tokof + (size_t)e * 32768 + j * BM; u.pa = Art; } else { u.list = nullptr; u.pa = Art + (size_t)(cs + j * BM) * Kb; }
        return true;
    }
};
}

constexpr int NTOK = 32768, DM = 1024, NBATCH = 8, SEQ = 4096, DEPTH = 4, NEXP = 64, TOPK = 8;
constexpr float EPS = 1e-6f;
constexpr int NWAVES = 8;
constexpr int NPHASE = 30;

constexpr size_t MiB = 1u << 20;
constexpr size_t WS_CTL = 0, CTL_ZERO_BYTES = 1 * MiB;
constexpr size_t WS_MOD = 1 * MiB;
constexpr size_t WS_PEP = 2 * MiB, WS_PW = 3 * MiB;
constexpr size_t WS_TOKOF = 4 * MiB;
constexpr size_t WS_WINE = 12 * MiB;
constexpr size_t WS_WOUTE = 22 * MiB;
constexpr size_t WS_WINO = 26 * MiB;
constexpr size_t WS_WC = 30 * MiB;
constexpr size_t WS_WR = 34 * MiB;
constexpr size_t WS_WS13 = 35 * MiB;
constexpr size_t WS_WS2 = 39 * MiB;
constexpr size_t WS_VEC = 42 * MiB;
constexpr size_t WS_W13 = 44 * MiB;
constexpr size_t WS_W2 = 108 * MiB;
constexpr size_t WS_H = 140 * MiB;
constexpr size_t WS_Y = 204 * MiB;
constexpr size_t WS_R = 268 * MiB;
constexpr size_t WS_QKV = WS_R, WS_UE = WS_R + 96 * MiB, WS_MIX = WS_R + 128 * MiB;
constexpr size_t WS_UO = WS_R, WS_POOL = WS_R + 64 * MiB;
constexpr size_t WS_HR = WS_R, WS_HS = WS_R + 129 * MiB, WS_SOUT = WS_R + 145 * MiB, WS_PAIR = WS_R + 209 * MiB;
constexpr size_t WS_X = WS_PAIR + 256 * MiB;
constexpr size_t WS_H8 = WS_X + 64 * MiB;
constexpr size_t WS_END = WS_H8 + 32 * MiB;
constexpr int CW_BAR = 4096;
constexpr int CW_CNT = 8192;

constexpr int SCR_BYTES = 139264;
constexpr int TAB_OFF = SCR_BYTES;
constexpr int MISC_OFF = TAB_OFF + 1024;
constexpr int LDS_BYTES = 147456;

#define XB_TMO      128
#define XB_XCNT(j)  (256  + 64 * (j))
#define XB_XSUB(j)  (1280 + 64 * (j))
#define XB_XGEN(j)  (2304 + 64 * (j))
#define XB_TOP      3328
#define XB_TOPGEN   3392
#define XCD_BAR_WORDS 3456
#define XB_SPIN_CAP (1u << 18)
__device__ __forceinline__ unsigned xb_ld(unsigned* p)              { return __hip_atomic_load(p, __ATOMIC_RELAXED, __HIP_MEMORY_SCOPE_AGENT); }
__device__ __forceinline__ unsigned xb_add(unsigned* p, unsigned v) { return __hip_atomic_fetch_add(p, v, __ATOMIC_RELAXED, __HIP_MEMORY_SCOPE_AGENT); }
__device__ __forceinline__ unsigned xb_xcc_id() { return (unsigned)__builtin_amdgcn_s_getreg((3 << 11) | 20) & 0xFu; }
#define XB_SPIN(cond, bar) do { unsigned _sp = 0; while (cond) { __builtin_amdgcn_s_sleep(1); \
    if ((++_sp & 255u) == 0u) { if (xb_ld(&(bar)[XB_TMO])) break; if (_sp > XB_SPIN_CAP) { atomicAdd(&(bar)[XB_TMO], 1u); break; } } } } while (0)
struct XcdBarrier { unsigned* bar; unsigned x; volatile LAS unsigned* st; };
__device__ __forceinline__ XcdBarrier xcd_barrier_post(unsigned* bar, volatile LAS unsigned* st) {
    XcdBarrier b; b.bar = bar; b.x = xb_xcc_id(); b.st = st;
    if (threadIdx.x == 0) (void)xb_add(&bar[XB_XCNT(b.x)], 1u);
    return b;
}
__device__ __forceinline__ void xcd_barrier_complete(unsigned* bar, unsigned x, unsigned& nloc, unsigned& nx) {
    const unsigned G = gridDim.x * gridDim.y * gridDim.z;
    unsigned sum, cnt, mine, sp = 0u;
    for (;;) {
        sum = 0u; cnt = 0u; mine = 0u;
#pragma unroll
        for (unsigned j = 0; j < 16; ++j) { const unsigned c = xb_ld(&bar[XB_XCNT(j)]); sum += c; cnt += (c > 0u) ? 1u : 0u; mine = (j == x) ? c : mine; }
        if (sum == G) break;
        __builtin_amdgcn_s_sleep(1);
        if ((++sp & 255u) == 0u) { if (xb_ld(&bar[XB_TMO])) break; if (sp > XB_SPIN_CAP) { atomicAdd(&bar[XB_TMO], 1u); break; } }
    }
    nloc = mine > 0u ? mine : 1u; nx = cnt > 0u ? cnt : 1u;
}
__device__ __forceinline__ void xcd_barrier(const XcdBarrier& b) {
    asm volatile("s_waitcnt vmcnt(0)" ::: "memory");
    __syncthreads();
    if (threadIdx.x == 0) {
        unsigned* bar = b.bar;
        __builtin_amdgcn_s_waitcnt(0);
        unsigned nloc = b.st[0], nx = b.st[1];
        if (nloc == 0u) { xcd_barrier_complete(bar, b.x, nloc, nx); b.st[0] = nloc; b.st[1] = nx; }
        const unsigned old = xb_add(&bar[XB_XSUB(b.x)], 1u);
        const unsigned gen = old / nloc;
        if (old + 1u == (gen + 1u) * nloc) {
            __builtin_amdgcn_fence(__ATOMIC_RELEASE, "agent");
            asm volatile("s_waitcnt vmcnt(0)" ::: "memory");
            const unsigned og = xb_add(&bar[XB_TOP], 1u);
            const unsigned tg = og / nx;
            if (og + 1u == (tg + 1u) * nx) xb_add(&bar[XB_TOPGEN], 1u);
            else XB_SPIN(xb_ld(&bar[XB_TOPGEN]) == tg, bar);
            __builtin_amdgcn_fence(__ATOMIC_ACQUIRE, "agent");
            xb_add(&bar[XB_XGEN(b.x)], 1u);
            asm volatile("s_waitcnt vmcnt(0)" ::: "memory");
        } else {
            XB_SPIN(xb_ld(&bar[XB_XGEN(b.x)]) == gen, bar);
            __builtin_amdgcn_fence(__ATOMIC_ACQUIRE, "agent");
            asm volatile("s_waitcnt vmcnt(0)" ::: "memory");
        }
    }
    __syncthreads();
}

struct Ctx {
    LAS unsigned char* lds; LAS int* tab;
    int tid, lane, wave, vcu, G;
    const float* xin; const float* w1; const float* w3; const float* w2;
    float* X;
    unsigned char* ws;
};
constexpr int V_N1G = 0, V_N2G = 4096, V_DWW = 8192, V_DWB = V_DWW + 2 * 31 * 512, V_LNG = V_DWB + 1024, V_LNB = V_LNG + 1024, V_BIAS = V_LNB + 1024, V_FING = V_BIAS + 256, V_END = V_FING + 1024;
#define VEC(off) ((const float*)(C.ws + WS_VEC) + (off))
#define WSB(off) ((bf16*)(C.ws + (off)))
__device__ __forceinline__ Ctx phase_ctx(const Ctx& C0) { Ctx C = C0;
    { int t_ = (int)threadIdx.x; asm volatile("" : "+v"(t_)); C.tid = t_; C.lane = t_ & 63; }
    { GAS unsigned char* g_ = (GAS unsigned char*)C.ws; asm volatile("" : "+s"(g_)); C.ws = (unsigned char*)g_; }
    { GAS float* g_ = (GAS float*)C.X; asm volatile("" : "+s"(g_)); C.X = (float*)g_; }
    { const GAS float* g_ = (const GAS float*)C.xin; asm volatile("" : "+s"(g_)); C.xin = (const float*)g_; }
    asm volatile("" : "+s"(C.wave), "+s"(C.vcu)); return C; }

__device__ __forceinline__ void tr_item(const float* W, int N, int K, int k0, int n0, bf16* WT, int drow, LAS float* scr, int lane) {
#pragma unroll 8
    for (int i = 0; i < 32; ++i) { const int kk = 2 * i + (lane >> 5); scr[kk * 33 + (lane & 31)] = W[(size_t)(k0 + kk) * N + n0 + (lane & 31)]; }
    LDS_WAIT(); asm volatile("" ::: "memory");
    const int c = lane & 7;
#pragma unroll
    for (int j = 0; j < 4; ++j) { const int n = (lane >> 3) + 8 * j; const LAS float* s = scr + (8 * c) * 33 + n;
        u32x4 o; o.x = pk2(s[0 * 33], s[1 * 33]); o.y = pk2(s[2 * 33], s[3 * 33]); o.z = pk2(s[4 * 33], s[5 * 33]); o.w = pk2(s[6 * 33], s[7 * 33]);
        *(GAS u32x4*)(WT + (size_t)(drow + n) * K + k0 + 8 * c) = o; }
    LDS_WAIT(); asm volatile("" ::: "memory");
}
__device__ __forceinline__ void tr_item8(const float* W, int N, int K, int k0, int n0, unsigned char* WT8, int drow, LAS float* scr, int lane, int shift) {
#pragma unroll 8
    for (int i = 0; i < 32; ++i) { const int kk = 2 * i + (lane >> 5); scr[kk * 33 + (lane & 31)] = W[(size_t)(k0 + kk) * N + n0 + (lane & 31)]; }
    LDS_WAIT(); asm volatile("" ::: "memory");
    const int c = lane & 3; const float sc = (float)(1 << shift);
#pragma unroll
    for (int j = 0; j < 2; ++j) { const int n = (lane >> 2) + 16 * j; const LAS float* s = scr + (16 * c) * 33 + n; u32x4 o;
#pragma unroll
        for (int q = 0; q < 4; ++q) { int t_ = __builtin_amdgcn_cvt_pk_fp8_f32(s[(4 * q) * 33] * sc, s[(4 * q + 1) * 33] * sc, 0, false); o[q] = (unsigned)__builtin_amdgcn_cvt_pk_fp8_f32(s[(4 * q + 2) * 33] * sc, s[(4 * q + 3) * 33] * sc, t_, true); }
        *(GAS u32x4*)(WT8 + (size_t)(drow + n) * K + k0 + 16 * c) = o; }
    LDS_WAIT(); asm volatile("" ::: "memory");
}
struct CvItem { const float* W; unsigned char* D; int N, K, k0, n0, drow, shift; };
__device__ __forceinline__ CvItem cv_decode(const Ctx& C, int l, int it) {
    CvItem v; const int e = it / 384, r = it % 384, which = r >> 7, q = r & 127;
    if (which < 2) { const int kb = q >> 1, nb = q & 1; v.W = (which == 0 ? C.w1 : C.w3) + (size_t)(l * 64 + e) * 1024 * 256; v.N = 256; v.K = 1024; v.k0 = 16 * kb; v.n0 = 128 * nb;
        v.D = C.ws + WS_W13 + (size_t)(l & 1) * (32 * MiB) + (size_t)e * 512 * 1024; v.drow = nb * 256 + (which ? 128 : 0); v.shift = pg8::FP8_SHIFT_G1; }
    else { const int kb = q >> 3, nb = q & 7; v.W = C.w2 + (size_t)(l * 64 + e) * 256 * 1024; v.N = 1024; v.K = 256; v.k0 = 16 * kb; v.n0 = 128 * nb;
        v.D = C.ws + WS_W2 + (size_t)(l & 1) * (16 * MiB) + (size_t)e * 1024 * 256; v.drow = 128 * nb; v.shift = pg8::FP8_SHIFT_G2; }
    return v;
}
__device__ __forceinline__ void cv_load(const CvItem& v, f32x4 (&x)[8], int lane) {
#pragma unroll
    for (int i = 0; i < 8; ++i) x[i] = *(const f32x4*)(v.W + (size_t)(v.k0 + 2 * i + (lane >> 5)) * v.N + v.n0 + 4 * (lane & 31));
}
__device__ __forceinline__ void cv_finish(const CvItem& v, const f32x4 (&x)[8], LAS float* scr, int lane) {
#pragma unroll
    for (int i = 0; i < 8; ++i) *(LAS f32x4*)(scr + (2 * i + (lane >> 5)) * 132 + 4 * (lane & 31)) = x[i];
    LDS_WAIT(); asm volatile("" ::: "memory");
    const float sc = (float)(1 << v.shift);
#pragma unroll
    for (int j = 0; j < 2; ++j) { const int n = lane + 64 * j; const LAS float* s = scr + n; u32x4 o;
#pragma unroll
        for (int q = 0; q < 4; ++q) { int t_ = __builtin_amdgcn_cvt_pk_fp8_f32(s[(4 * q) * 132] * sc, s[(4 * q + 1) * 132] * sc, 0, false); o[q] = (unsigned)__builtin_amdgcn_cvt_pk_fp8_f32(s[(4 * q + 2) * 132] * sc, s[(4 * q + 3) * 132] * sc, t_, true); }
        *(GAS u32x4*)(v.D + (size_t)(v.drow + n) * v.K + v.k0) = o; }
    LDS_WAIT(); asm volatile("" ::: "memory");
}
__device__ __forceinline__ void moe_convert(const Ctx& C, int l, LAS float* scr, int gw, int NGW, int first = 0, int count = 64 * 384) {
    const int end = first + count;
    for (int it = first + gw; it < end; it += 4 * NGW) {
        const CvItem v0 = cv_decode(C, l, it), v1 = cv_decode(C, l, it + NGW < end ? it + NGW : end - 1), v2 = cv_decode(C, l, it + 2 * NGW < end ? it + 2 * NGW : end - 1), v3 = cv_decode(C, l, it + 3 * NGW < end ? it + 3 * NGW : end - 1);
        f32x4 x0[8], x1[8], x2[8], x3[8];
        cv_load(v0, x0, C.lane); cv_load(v1, x1, C.lane); cv_load(v2, x2, C.lane); cv_load(v3, x3, C.lane);
        cv_finish(v0, x0, scr, C.lane);
        if (it + NGW < end) cv_finish(v1, x1, scr, C.lane);
        if (it + 2 * NGW < end) cv_finish(v2, x2, scr, C.lane);
        if (it + 3 * NGW < end) cv_finish(v3, x3, scr, C.lane);
    }
}
template <class ArgsT>
__device__ __forceinline__ void prologue(const Ctx& C, const ArgsT& A) {
    LAS float* condT = (LAS float*)C.lds;
    LAS float* scr = (LAS float*)(C.lds + 32768 + C.wave * 8448);
    { float cv[16];
#pragma unroll
      for (int q = 0; q < 16; ++q) cv[q] = A.in[1][C.tid + NWAVES * 64 * q];
#pragma unroll
      for (int q = 0; q < 16; ++q) { const int idx = C.tid + NWAVES * 64 * q, b = idx >> 10, k = idx & 1023; condT[k * 8 + b] = cv[q] * sigmoidf_(cv[q]); } }
    __syncthreads();
    const int gw = C.vcu * NWAVES + C.wave, NGW = C.G * NWAVES;
    float* MOD = (float*)(C.ws + WS_MOD);
    for (int it = gw; it < 4 * 384; it += NGW) {
        const int l = it / 384, c0 = (it % 384) * 16, cc = C.lane & 15, kq = C.lane >> 4;
        const float* wp = A.in[2] + ((size_t)l * 1024 + kq * 256) * 6144 + c0 + cc;
        float acc[8];
#pragma unroll
        for (int b = 0; b < 8; ++b) acc[b] = 0.f;
#pragma unroll 8
        for (int kk = 0; kk < 256; ++kk) { const float w = wp[(size_t)kk * 6144]; const LAS f32x4* cv = (const LAS f32x4*)(condT + (kq * 256 + kk) * 8); const f32x4 c0v = cv[0], c1v = cv[1];
            acc[0] += w * c0v[0]; acc[1] += w * c0v[1]; acc[2] += w * c0v[2]; acc[3] += w * c0v[3]; acc[4] += w * c1v[0]; acc[5] += w * c1v[1]; acc[6] += w * c1v[2]; acc[7] += w * c1v[3]; }
#pragma unroll
        for (int b = 0; b < 8; ++b) { acc[b] += __shfl_xor(acc[b], 16); acc[b] += __shfl_xor(acc[b], 32); }
        if (C.lane < 16) { const float bb = A.in[3][l * 6144 + c0 + cc];
#pragma unroll
            for (int b = 0; b < 8; ++b) MOD[(size_t)(l * 8 + b) * 6144 + c0 + cc] = acc[b] + bb; }
    }
    { LAS float* wt = (LAS float*)(C.lds + 102400);
      for (int bi = C.vcu; bi < 256; bi += C.G) {
        const int nq = bi & 3, kt = (bi >> 2) & 7, g = (bi >> 5) & 3, i = bi >> 7, r = C.lane & 31, h = C.lane >> 5, nt_ = nq * 8 + C.wave;
        __syncthreads();
        { const float* wgb = A.in[13] + ((size_t)(i * 4 + g) * 256 + kt * 32) * 256; const float* scb = A.in[14] + i * 1024 + g * 256;
#pragma unroll
          for (int q = 0; q < 4; ++q) { const int idx = C.tid + 512 * q, row = idx >> 6, c4 = idx & 63; const f32x4 v = *(const f32x4*)(wgb + row * 256 + 4 * c4), sc4 = *(const f32x4*)(scb + 4 * c4);
              LAS float* d = wt + row * 257 + 4 * c4; d[0] = v[0] * sc4[0]; d[1] = v[1] * sc4[1]; d[2] = v[2] * sc4[2]; d[3] = v[3] * sc4[3]; } }
        __syncthreads();
        const float* wo = A.in[15] + ((size_t)i * 1024 + g * 256 + h) * 1024 + nt_ * 32 + r; const LAS float* wb = wt + r * 257 + h;
        f32x16 acc;
#pragma unroll
        for (int q = 0; q < 16; ++q) acc[q] = 0.f;
#pragma unroll 16
        for (int s_ = 0; s_ < 128; ++s_) acc = __builtin_amdgcn_mfma_f32_32x32x2f32(wo[(size_t)(2 * s_) * 1024], wb[2 * s_], acc, 0, 0, 0);
        unsigned char* wc = C.ws + WS_WC + ((size_t)i * 1024 + nt_ * 32 + 4 * h) * 1024 + g * 256 + kt * 32 + r;
#pragma unroll
        for (int q = 0; q < 16; ++q) wc[(size_t)((q & 3) + 8 * (q >> 2)) * 1024] = (unsigned char)(__builtin_amdgcn_cvt_pk_fp8_f32(acc[q] * (float)(1 << pg8::FP8_SHIFT_G1), 0.f, 0, false) & 0xff);
      }
      __syncthreads(); }
    constexpr int S0 = 2560, S1 = S0 + 1024, S2 = S1 + 1024, S3 = S2 + 128, S4 = S3 + 512, S5 = S4 + 512, S6 = S5 + 512;
    for (int it = gw; it < S6; it += NGW) {
        if (it < S0) { const int i = it / 1280, q = it % 1280, kb = q / 80, nb = q % 80, n0 = 32 * nb; int drow;
            if (n0 < 1536) drow = n0; else { int j = n0 - 1536; const int gate = j >= 512; if (gate) j -= 512; drow = 1536 + (j >> 7) * 256 + ((j & 127) >> 5) * 64 + (gate ? 32 : 0) + (j & 31); }
            tr_item8(A.in[6] + (size_t)i * 1024 * 2560, 2560, 1024, 64 * kb, n0, C.ws + WS_WINE + (size_t)i * 2560 * 1024, drow, scr, C.lane, pg8::FP8_SHIFT_G1); }
        else if (it < S1) { const int q = it - S0, i = q >> 9, r = q & 511; tr_item8(A.in[11] + (size_t)i * 1024 * 1024, 1024, 1024, 64 * (r >> 5), 32 * (r & 31), C.ws + WS_WOUTE + (size_t)i * 1024 * 1024, 32 * (r & 31), scr, C.lane, pg8::FP8_SHIFT_G1); }
        else if (it < S2) { const int q = it - S1, i = q >> 9, r = q & 511; tr_item8(A.in[12] + (size_t)i * 1024 * 1024, 1024, 1024, 64 * (r >> 5), 32 * (r & 31), C.ws + WS_WINO + (size_t)i * 1024 * 1024, 32 * (r & 31), scr, C.lane, pg8::FP8_SHIFT_G1); }
        else if (it < S3) { const int q = it - S2, l = q >> 5, r = q & 31; tr_item(A.in[16] + (size_t)l * 1024 * 64, 64, 1024, 64 * (r >> 1), 32 * (r & 1), WSB(WS_WR) + (size_t)l * 64 * 1024, 32 * (r & 1), scr, C.lane); }
        else if (it < S5) { const int which = it >= S4, q = it - (which ? S4 : S3), l = q >> 7, r = q & 127, n0 = 32 * (r & 7);
            tr_item8(A.in[which ? 22 : 21] + (size_t)l * 1024 * 256, 256, 1024, 64 * (r >> 3), n0, C.ws + WS_WS13 + (size_t)l * 512 * 1024, (n0 >> 7) * 256 + (n0 & 127) + (which ? 128 : 0), scr, C.lane, pg8::FP8_SHIFT_G1); }
        else { const int q = it - S5, l = q >> 7, r = q & 127; tr_item8(A.in[23] + (size_t)l * 256 * 1024, 1024, 256, 64 * (r >> 5), 32 * (r & 31), C.ws + WS_WS2 + (size_t)l * 1024 * 256, 32 * (r & 31), scr, C.lane, pg8::FP8_SHIFT_G2); }
    }
    { float* V = (float*)(C.ws + WS_VEC); const int gt = C.vcu * NWAVES * 64 + C.tid, NT = C.G * NWAVES * 64;
      for (int i = gt; i < V_END; i += NT) { float v;
          if (i < V_N2G) v = A.in[4][i]; else if (i < V_DWW) v = A.in[5][i - V_N2G]; else if (i < V_DWB) v = A.in[7][i - V_DWW]; else if (i < V_LNG) v = A.in[8][i - V_DWB];
          else if (i < V_LNB) v = A.in[9][i - V_LNG]; else if (i < V_BIAS) v = A.in[10][i - V_LNB]; else if (i < V_FING) v = A.in[17][i - V_BIAS]; else v = A.in[24][i - V_FING];
          V[i] = v; } }
    moe_convert(C, 0, scr, gw, NGW);
}

__device__ __forceinline__ void build_tables(const Ctx& C, int l) {
    __syncthreads();
    if (C.wave == 0) {
        const int n = (int)__hip_atomic_load((unsigned*)(C.ws + WS_CTL) + CW_CNT + (l * 64 + C.lane) * 16, RLX_AGENT);
        int tl = (n + 255) >> 8, cn = n;
#pragma unroll
        for (int o = 1; o < 64; o <<= 1) { const int sl = (C.lane >= o ? C.lane - o : C.lane) << 2;
            const int a = __builtin_amdgcn_ds_bpermute(sl, tl), b = __builtin_amdgcn_ds_bpermute(sl, cn); if (C.lane >= o) { tl += a; cn += b; } }
        C.tab[1 + C.lane] = tl; C.tab[81 + C.lane] = cn; C.tab[160 + C.lane] = n;
        { LAS unsigned short* tmap = (LAS unsigned short*)(C.tab + 512); const int nt_ = (n + 255) >> 8; for (int j = tl - nt_; j < tl; ++j) tmap[j] = (unsigned short)C.lane; }
        if (C.lane == 0) { C.tab[0] = 0; C.tab[80] = 0; }
    }
    __syncthreads();
}

__device__ __forceinline__ void unpack16(const u32x4& a, const u32x4& b, f32x4 (&v)[4]) {
    v[0] = (f32x4){bflo(a.x), bfhi(a.x), bflo(a.y), bfhi(a.y)}; v[1] = (f32x4){bflo(a.z), bfhi(a.z), bflo(a.w), bfhi(a.w)};
    v[2] = (f32x4){bflo(b.x), bfhi(b.x), bflo(b.y), bfhi(b.y)}; v[3] = (f32x4){bflo(b.z), bfhi(b.z), bflo(b.w), bfhi(b.w)}; }
__device__ __forceinline__ void pack16(const f32x4 (&v)[4], u32x4& a, u32x4& b) {
    a.x = pk2(v[0][0], v[0][1]); a.y = pk2(v[0][2], v[0][3]); a.z = pk2(v[1][0], v[1][1]); a.w = pk2(v[1][2], v[1][3]);
    b.x = pk2(v[2][0], v[2][1]); b.y = pk2(v[2][2], v[2][3]); b.z = pk2(v[3][0], v[3][1]); b.w = pk2(v[3][2], v[3][3]); }
__device__ __forceinline__ f32x4 fp8x4(unsigned w) { const f32x2 lo = __builtin_amdgcn_cvt_pk_f32_fp8((int)w, false), hi = __builtin_amdgcn_cvt_pk_f32_fp8((int)w, true); return (f32x4){lo.x, lo.y, hi.x, hi.y}; }
template <int MODE, bool DRY = false>
__device__ __forceinline__ void row_phase(const Ctx& C, int l) {
    const float* MOD = (const float*)(C.ws + WS_MOD);
    bf16* H = WSB(WS_H); bf16* X = WSB(WS_X);
    bf16* Xd = DRY ? WSB(WS_R) : X; bf16* Hd = DRY ? WSB(WS_R + 64 * MiB) : H; float* PWd = DRY ? (float*)(C.ws + WS_R + 128 * MiB) : (float*)(C.ws + WS_PW);
    const int lane = C.lane, e0 = 16 * lane;
    LAS unsigned char* tileA = C.lds;
    LAS float* part = (LAS float*)(C.lds + 66048);
    if (MODE == 1 || MODE == 3) build_tables(C, l - 1);
    unsigned selbits = 0u;
    const int ntile = NTOK / 32;
    bf16x8 wrf[2][8];
    if (MODE == 2) { const int r_ = lane & 31, hi_ = lane >> 5; const bf16* wr = WSB(WS_WR) + (size_t)l * 64 * 1024;
#pragma unroll
        for (int s_ = 0; s_ < 8; ++s_) { const int kc = 128 * C.wave + 16 * s_ + 8 * hi_; wrf[0][s_] = *(const bf16x8*)(wr + (size_t)r_ * 1024 + kc); wrf[1][s_] = *(const bf16x8*)(wr + (size_t)(32 + r_) * 1024 + kc); } }
    u32x4 rx[4][2];
    if (MODE == 2) { const int tile = C.vcu; if (tile < ntile) { const size_t tb = (size_t)(tile * 32 + C.wave * 4) * DM + e0;
#pragma unroll
        for (int t = 0; t < 4; ++t) { rx[t][0] = *(const u32x4*)(X + tb + t * DM); rx[t][1] = *(const u32x4*)(X + tb + t * DM + 8); } } }
    for (int it = 0; ; ++it) {
        const int tile = C.vcu + it * C.G; if (tile >= ntile) break;
        const int b = tile >> 7, tokb = tile * 32 + C.wave * 4;
        f32x4 ga[4], av[4], sh[4];
#pragma unroll
        for (int q = 0; q < 4; ++q) { const int c = e0 + 4 * q;
            if (MODE == 0 || MODE == 1) { const float* m = MOD + (size_t)(l * 8 + b) * 6144; const f32x4 g = *(const f32x4*)(VEC(V_N1G) + l * 1024 + c);
                sh[q] = *(const f32x4*)(m + c); av[q] = g * (*(const f32x4*)(m + 1024 + c) + 1.f);
                if (MODE == 1) ga[q] = *(const f32x4*)(MOD + (size_t)((l - 1) * 8 + b) * 6144 + 5 * 1024 + c); else ga[q] = (f32x4){0.f, 0.f, 0.f, 0.f}; }
            else if (MODE == 2) { const float* m = MOD + (size_t)(l * 8 + b) * 6144; const f32x4 g = *(const f32x4*)(VEC(V_N2G) + l * 1024 + c);
                ga[q] = *(const f32x4*)(m + 2 * 1024 + c); sh[q] = *(const f32x4*)(m + 3 * 1024 + c); av[q] = g * (*(const f32x4*)(m + 4 * 1024 + c) + 1.f); }
            else { ga[q] = *(const f32x4*)(MOD + (size_t)(3 * 8 + b) * 6144 + 5 * 1024 + c); av[q] = *(const f32x4*)(VEC(V_FING) + c); sh[q] = (f32x4){0.f, 0.f, 0.f, 0.f}; }
        }
#define ROW_FINISH(NB, T0) do { float ss[NB]; \
            _Pragma("unroll") for (int t = 0; t < NB; ++t) { float a_ = 0.f; _Pragma("unroll") for (int q = 0; q < 4; ++q) a_ += (x[t][q][0] * x[t][q][0] + x[t][q][1] * x[t][q][1]) + (x[t][q][2] * x[t][q][2] + x[t][q][3] * x[t][q][3]); ss[t] = a_; } \
            _Pragma("unroll") for (int t = 0; t < NB; ++t) ss[t] = wave_sum(ss[t]); \
            _Pragma("unroll") for (int t = 0; t < NB; ++t) { const int tok = tokb + (T0) + t; const float rs = __builtin_amdgcn_rsqf(ss[t] * (1.f / DM) + EPS); \
                if (MODE == 3) { _Pragma("unroll") for (int q = 0; q < 4; ++q) *(f32x4*)(C.X + (size_t)tok * DM + e0 + 4 * q) = x[t][q] * rs * av[q]; } \
                else { if (MODE != 2) { u32x4 xa, xb; pack16(x[t], xa, xb); *(u32x4*)(Xd + (size_t)tok * DM + e0) = xa; *(u32x4*)(Xd + (size_t)tok * DM + e0 + 8) = xb; } \
                    f32x4 hv[4]; _Pragma("unroll") for (int q = 0; q < 4; ++q) hv[q] = x[t][q] * rs * av[q] + sh[q]; \
                    u32x4 ha, hb; pack16(hv, ha, hb); if (MODE != 2) { u32x4 h8_; _Pragma("unroll") for (int q = 0; q < 4; ++q) { int t_ = __builtin_amdgcn_cvt_pk_fp8_f32(hv[q][0], hv[q][1], 0, false); h8_[q] = (unsigned)__builtin_amdgcn_cvt_pk_fp8_f32(hv[q][2], hv[q][3], t_, true); } \
                        *(u32x4*)((unsigned char*)Hd + (size_t)tok * DM + e0) = h8_; } \
                    if (MODE == 2) { LAS unsigned char* tp = tileA + (C.wave * 4 + (T0) + t) * 2064 + e0 * 2; *(LAS u32x4*)tp = ha; *(LAS u32x4*)(tp + 16) = hb; \
                        if (!DRY) { u32x4 h8; _Pragma("unroll") for (int q = 0; q < 4; ++q) { int t_ = __builtin_amdgcn_cvt_pk_fp8_f32(hv[q][0], hv[q][1], 0, false); h8[q] = (unsigned)__builtin_amdgcn_cvt_pk_fp8_f32(hv[q][2], hv[q][3], t_, true); } \
                            *(u32x4*)(C.ws + WS_H8 + (size_t)tok * DM + e0) = h8; } } } } } while (0)
        if (MODE == 0) {
            f32x4 x[4][4];
#pragma unroll
            for (int t = 0; t < 4; ++t)
#pragma unroll
                for (int q = 0; q < 4; ++q) x[t][q] = *(const f32x4*)(C.xin + (size_t)(tokb + t) * DM + e0 + 4 * q);
            ROW_FINISH(4, 0);
        } else if (MODE == 2) {
#pragma unroll
            for (int hb2 = 0; hb2 < 2; ++hb2) { f32x4 x[2][4];
#pragma unroll
                for (int t = 0; t < 2; ++t) unpack16(rx[2 * hb2 + t][0], rx[2 * hb2 + t][1], x[t]);
                ROW_FINISH(2, 2 * hb2); }
            { const int tn = tile + C.G; if (tn < ntile) { const size_t tb = (size_t)(tn * 32 + C.wave * 4) * DM + e0;
#pragma unroll
                for (int t = 0; t < 4; ++t) { rx[t][0] = *(const u32x4*)(X + tb + t * DM); rx[t][1] = *(const u32x4*)(X + tb + t * DM + 8); } } }
        } else {
            const int* pep = (const int*)(C.ws + WS_PEP) + (size_t)tokb * 8; const float* pw = (const float*)(C.ws + WS_PW) + (size_t)tokb * 8;
            const int epv = pep[lane & 31]; const float pwv = pw[lane & 31];
#pragma unroll
            for (int hb2 = 0; hb2 < 2; ++hb2) {
                u32x4 qx[2][2], qs[2][2], qp[2][8];
#pragma unroll
                for (int t = 0; t < 2; ++t) { const size_t tb = (size_t)(tokb + 2 * hb2 + t) * DM + e0;
                    qx[t][0] = *(const u32x4*)(X + tb); qx[t][1] = *(const u32x4*)(X + tb + 8); qs[t][0] = *(const u32x4*)(WSB(WS_SOUT) + tb); qs[t][1] = *(const u32x4*)(WSB(WS_SOUT) + tb + 8);
#pragma unroll
                    for (int k = 0; k < 8; ++k) { const int ep = __builtin_amdgcn_readlane(epv, 8 * (2 * hb2 + t) + k); const int row = C.tab[80 + (ep >> 16)] + (ep & 0xffff);
                        qp[t][k] = *(const u32x4*)(C.ws + WS_PAIR + (size_t)row * DM + e0); } }
                f32x4 x[2][4];
#pragma unroll
                for (int t = 0; t < 2; ++t) { f32x4 v[4]; unpack16(qx[t][0], qx[t][1], x[t]); unpack16(qs[t][0], qs[t][1], v);
#pragma unroll
                    for (int k = 0; k < 8; ++k) { const float w = __builtin_bit_cast(float, __builtin_amdgcn_readlane(__builtin_bit_cast(int, pwv), 8 * (2 * hb2 + t) + k));
                        v[0] += w * fp8x4(qp[t][k].x); v[1] += w * fp8x4(qp[t][k].y); v[2] += w * fp8x4(qp[t][k].z); v[3] += w * fp8x4(qp[t][k].w); }
#pragma unroll
                    for (int q = 0; q < 4; ++q) x[t][q] += ga[q] * v[q]; }
                ROW_FINISH(2, 2 * hb2);
            }
        }
#undef ROW_FINISH
        if (MODE == 2) {
#define LDS_BARRIER() do { LDS_WAIT(); __builtin_amdgcn_s_barrier(); } while (0)
            LDS_BARRIER();
            { const int r = lane & 31, hi = lane >> 5;
              f32x16 a0, a1;
#pragma unroll
              for (int i = 0; i < 16; ++i) { a0[i] = 0.f; a1[i] = 0.f; }
#pragma unroll
              for (int s = 0; s < 8; ++s) { const int kc = 128 * C.wave + 16 * s + 8 * hi;
                  const bf16x8 af = *(const LAS bf16x8*)(tileA + r * 2064 + kc * 2);
                  a0 = __builtin_amdgcn_mfma_f32_32x32x16_bf16(af, wrf[0][s], a0, 0, 0, 0); a1 = __builtin_amdgcn_mfma_f32_32x32x16_bf16(af, wrf[1][s], a1, 0, 0, 0); }
#pragma unroll
              for (int i = 0; i < 16; ++i) { const int trow = (i & 3) + 8 * (i >> 2) + 4 * hi; part[(C.wave * 32 + trow) * 64 + r] = a0[i]; part[(C.wave * 32 + trow) * 64 + 32 + r] = a1[i]; } }
            LDS_BARRIER();
            const float bias = VEC(V_BIAS)[l * 64 + lane];
#pragma unroll
            for (int ti = 0; ti < 4; ++ti) {
                const int trow = C.wave * 4 + ti, tok = tile * 32 + trow;
                float logit = 0.f;
#pragma unroll
                for (int w = 0; w < 8; ++w) logit += part[(w * 32 + trow) * 64 + lane];
                const float sc = sigmoidf_(logit), bi = sc + bias;
#define DPPF(v, ctrl) __builtin_bit_cast(float, __builtin_amdgcn_update_dpp(0, __builtin_bit_cast(int, (v)), (ctrl), 0xf, 0xf, false))
                float m1 = bi; m1 = fmaxf(m1, DPPF(m1, 0xB1)); m1 = fmaxf(m1, DPPF(m1, 0x4E)); m1 = fmaxf(m1, DPPF(m1, 0x141));
                const unsigned long long eq = __ballot(bi == m1); const int grp = lane >> 3; const unsigned gm = (unsigned)(eq >> (grp * 8)) & 0xffu;
                const bool isfirst = (lane & 7) == (__ffs((int)gm) - 1);
                float m2 = isfirst ? -INFINITY : bi; m2 = fmaxf(m2, DPPF(m2, 0xB1)); m2 = fmaxf(m2, DPPF(m2, 0x4E)); m2 = fmaxf(m2, DPPF(m2, 0x141));
                const float gs = m1 + m2; int grank = 0;
#pragma unroll
                for (int g2 = 0; g2 < 8; ++g2) { const float o = __builtin_bit_cast(float, __builtin_amdgcn_readlane(__builtin_bit_cast(int, gs), 8 * g2)); grank += (o > gs || (o == gs && g2 < grp)) ? 1 : 0; }
                const bool gsel = grank < 4;
                const float key = gsel ? __builtin_bit_cast(float, (__builtin_bit_cast(unsigned, bi) & 0xFFFFFFC0u) | (unsigned)(63 - lane)) : -INFINITY; int rk = 0;
                const unsigned long long gb = __ballot(gsel);
#pragma unroll
                for (int g2 = 0; g2 < 8; ++g2) { if ((gb >> (8 * g2)) & 1ull) {
#pragma unroll
                    for (int e3 = 0; e3 < 8; ++e3) { const float o = __builtin_bit_cast(float, __builtin_amdgcn_readlane(__builtin_bit_cast(int, key), 8 * g2 + e3)); rk += (o > key) ? 1 : 0; } } }
                const bool sel = gsel && rk < 8;
                float ssum = sel ? sc : 0.f; ssum += DPPF(ssum, 0xB1); ssum += DPPF(ssum, 0x4E); ssum += DPPF(ssum, 0x141); ssum += DPPF(ssum, 0x140);
                ssum = __builtin_bit_cast(float, __builtin_amdgcn_readlane(__builtin_bit_cast(int, ssum), 0)) + __builtin_bit_cast(float, __builtin_amdgcn_readlane(__builtin_bit_cast(int, ssum), 16))
                     + __builtin_bit_cast(float, __builtin_amdgcn_readlane(__builtin_bit_cast(int, ssum), 32)) + __builtin_bit_cast(float, __builtin_amdgcn_readlane(__builtin_bit_cast(int, ssum), 48));
#undef DPPF
                const unsigned long long sm = __ballot(sel); const int kidx = __popcll(sm & ((1ull << lane) - 1ull));
                if (sel) PWd[(size_t)tok * 8 + kidx] = sc / ssum * 2.5f;
                selbits |= (sel ? 1u : 0u) << (it * 4 + ti);
            }
            LDS_BARRIER();
#undef LDS_BARRIER
        }
    }
    if (MODE == 2 && !DRY) {
        const unsigned cnt = (unsigned)__popc(selbits);
        LAS unsigned* wcn = (LAS unsigned*)C.lds;
        wcn[C.wave * 64 + lane] = cnt; __syncthreads();
        if (C.wave == 0) { unsigned tot = 0u;
#pragma unroll
            for (int w = 0; w < 8; ++w) { const unsigned v = wcn[w * 64 + lane]; wcn[w * 64 + lane] = tot; tot += v; }
            unsigned bb = 0u; if (tot) bb = __hip_atomic_fetch_add((unsigned*)(C.ws + WS_CTL) + CW_CNT + (l * 64 + lane) * 16, tot, RLX_AGENT);
            wcn[512 + lane] = bb; }
        __syncthreads();
        const unsigned base = wcn[512 + lane] + wcn[C.wave * 64 + lane];
        int* tokof = (int*)(C.ws + WS_TOKOF) + (size_t)lane * 32768; int* pep = (int*)(C.ws + WS_PEP);
        for (int it = 0; ; ++it) { const int tile = C.vcu + it * C.G; if (tile >= ntile) break;
#pragma unroll 1
            for (int ti = 0; ti < 4; ++ti) { const int slot = it * 4 + ti, tok = tile * 32 + C.wave * 4 + ti; const bool sel = (selbits >> slot) & 1u;
                const unsigned long long sm = __ballot(sel); const int kidx = __popcll(sm & ((1ull << lane) - 1ull));
                if (sel) { const unsigned pos = base + (unsigned)__popc(selbits & ((1u << slot) - 1u)); tokof[pos] = tok; pep[(size_t)tok * 8 + kidx] = (int)(((unsigned)lane << 16) | pos); } } }
    }
}

template <bool FINAL, bool DRY = false>
__device__ __forceinline__ void combine_phase(const Ctx& C, int l) {
    const float* MOD = (const float*)(C.ws + WS_MOD);
    bf16* H = WSB(WS_H); bf16* X = WSB(WS_X);
    bf16* Hd = DRY ? WSB(WS_R) : H; bf16* Xd = DRY ? WSB(WS_Y) : X; float* Od = DRY ? (float*)(C.ws + WS_R) : C.X;
    const int lane = C.lane, e0 = 16 * lane, ntile = NTOK / 32;
#if MK_PER_PHASE
    build_tables(C, l - 1);
#endif
    if (C.vcu >= ntile) return;
    u32x4 pA[8], xA[2], sA[1], pB[8], xB[2], sB[1];
    int epv, epn = 0; float pwv, pwn = 0.f;
#define CMB_LOAD(P_, X_, S_, TOK, TI, EPV) do { const size_t tb = (size_t)(TOK) * DM + e0; \
        X_[0] = *(const u32x4*)(X + tb); X_[1] = *(const u32x4*)(X + tb + 8); S_[0] = *(const u32x4*)(C.ws + WS_SOUT + tb); \
        _Pragma("unroll") for (int k = 0; k < 8; ++k) { const int ep = __builtin_amdgcn_readlane((EPV), 8 * (TI) + k); const int row = C.tab[80 + (ep >> 16)] + (ep & 0xffff); \
            P_[k] = *(const u32x4*)(C.ws + WS_PAIR + (size_t)row * DM + e0); } } while (0)
#define CMB_COMPUTE(P_, X_, S_, TI) do { f32x4 x[4], v[4]; unpack16(X_[0], X_[1], x); v[0] = fp8x4(S_[0].x); v[1] = fp8x4(S_[0].y); v[2] = fp8x4(S_[0].z); v[3] = fp8x4(S_[0].w); \
        _Pragma("unroll") for (int k = 0; k < 8; ++k) { const float w = __builtin_bit_cast(float, __builtin_amdgcn_readlane(__builtin_bit_cast(int, pwv), 8 * (TI) + k)); \
            v[0] += w * fp8x4(P_[k].x); v[1] += w * fp8x4(P_[k].y); v[2] += w * fp8x4(P_[k].z); v[3] += w * fp8x4(P_[k].w); } \
        float ss = 0.f; _Pragma("unroll") for (int q = 0; q < 4; ++q) { x[q] += ga[q] * v[q]; ss += (x[q][0] * x[q][0] + x[q][1] * x[q][1]) + (x[q][2] * x[q][2] + x[q][3] * x[q][3]); } \
        const float rs = __builtin_amdgcn_rsqf(wave_sum(ss) * (1.f / DM) + EPS); \
        if (FINAL) { _Pragma("unroll") for (int q = 0; q < 4; ++q) ro[q] = x[q] * rs * (*(const f32x4*)(VEC(V_FING) + e0 + 4 * q)); } \
        else { pack16(x, rxa, rxb); f32x4 hv[4]; _Pragma("unroll") for (int q = 0; q < 4; ++q) { const float* m_ = mrow + e0 + 4 * q; \
                hv[q] = x[q] * rs * (*(const f32x4*)(VEC(V_N1G) + l * 1024 + e0 + 4 * q) * (*(const f32x4*)(m_ + 1024) + 1.f)) + *(const f32x4*)m_; } \
            _Pragma("unroll") for (int q = 0; q < 4; ++q) { int t_ = __builtin_amdgcn_cvt_pk_fp8_f32(hv[q][0], hv[q][1], 0, false); rha[q] = (unsigned)__builtin_amdgcn_cvt_pk_fp8_f32(hv[q][2], hv[q][3], t_, true); } } } while (0)
#define CMB_STORE(TOK) do { const size_t tb = (size_t)(TOK) * DM + e0; \
        if (FINAL) { _Pragma("unroll") for (int q = 0; q < 4; ++q) *(f32x4*)(Od + tb + 4 * q) = ro[q]; } \
        else { *(u32x4*)(Xd + tb) = rxa; *(u32x4*)(Xd + tb + 8) = rxb; *(u32x4*)((unsigned char*)Hd + tb) = rha; } } while (0)
#define CMB_SB() __builtin_amdgcn_sched_barrier(0)
    { const int tokb0 = C.vcu * 32 + C.wave * 4; epv = ((const int*)(C.ws + WS_PEP))[(size_t)tokb0 * 8 + (lane & 31)]; pwv = ((const float*)(C.ws + WS_PW))[(size_t)tokb0 * 8 + (lane & 31)];
      CMB_LOAD(pA, xA, sA, tokb0, 0, epv); }
    for (int it = 0; ; ++it) {
        const int tile = C.vcu + it * C.G; if (tile >= ntile) break;
        const int tn = tile + C.G; const bool has_next = tn < ntile;
        const int b = tile >> 7, tokb = tile * 32 + C.wave * 4, tokn = tn * 32 + C.wave * 4;
        if (has_next) { epn = ((const int*)(C.ws + WS_PEP))[(size_t)tokn * 8 + (lane & 31)]; pwn = ((const float*)(C.ws + WS_PW))[(size_t)tokn * 8 + (lane & 31)]; }
        const float* mrow = MOD + (size_t)((FINAL ? 0 : l) * 8 + b) * 6144;
        f32x4 ga[4];
#pragma unroll
        for (int q = 0; q < 4; ++q) ga[q] = *(const f32x4*)(MOD + (size_t)((l - 1) * 8 + b) * 6144 + 5 * 1024 + e0 + 4 * q);
        f32x4 ro[4]; u32x4 rxa, rxb, rha, rhb;
        CMB_LOAD(pB, xB, sB, tokb + 1, 1, epv); CMB_SB(); CMB_COMPUTE(pA, xA, sA, 0); CMB_SB(); CMB_STORE(tokb + 0); CMB_SB();
        CMB_LOAD(pA, xA, sA, tokb + 2, 2, epv); CMB_SB(); CMB_COMPUTE(pB, xB, sB, 1); CMB_SB(); CMB_STORE(tokb + 1); CMB_SB();
        CMB_LOAD(pB, xB, sB, tokb + 3, 3, epv); CMB_SB(); CMB_COMPUTE(pA, xA, sA, 2); CMB_SB(); CMB_STORE(tokb + 2); CMB_SB();
        if (has_next) CMB_LOAD(pA, xA, sA, tokn, 0, epn);
        CMB_SB(); CMB_COMPUTE(pB, xB, sB, 3); CMB_SB(); CMB_STORE(tokb + 3); CMB_SB();
        epv = epn; pwv = pwn;
    }
#undef CMB_LOAD
#undef CMB_COMPUTE
#undef CMB_STORE
#undef CMB_SB
}

__device__ __forceinline__ void attn_wave_unit(const bf16* QKV, unsigned char* MIX, int b, int h, int qb, LAS unsigned char* vl, int lane) {
    const int r = lane & 31, hi = lane >> 5; const size_t tok0 = (size_t)b * SEQ; const int q0 = qb * 32;
    const bf16* qp = QKV + (tok0 + q0 + r) * 1536 + h * 64 + 8 * hi;
    bf16x8 qf[4];
#pragma unroll
    for (int kk = 0; kk < 4; ++kk) qf[kk] = *(const bf16x8*)(qp + 16 * kk);
    f32x16 o0, o1;
#pragma unroll
    for (int i = 0; i < 16; ++i) { o0[i] = 0.f; o1[i] = 0.f; }
    float P = 1.f;
    for (int kb = q0; kb >= 0; kb -= 32) {
        const bf16* kp = QKV + (tok0 + kb + r) * 1536 + 512 + h * 64 + 8 * hi;
        bf16x8 kf[4];
#pragma unroll
        for (int kk = 0; kk < 4; ++kk) kf[kk] = *(const bf16x8*)(kp + 16 * kk);
        const bf16* vp = QKV + (tok0 + kb + (lane >> 1)) * 1536 + 1024 + h * 64 + (lane & 1) * 32;
        u32x4 vv[4];
#pragma unroll
        for (int i = 0; i < 4; ++i) vv[i] = *(const u32x4*)(vp + 8 * i);
        LAS unsigned char* vrow = vl + (lane >> 1) * 144 + (lane & 1) * 64;
#pragma unroll
        for (int i = 0; i < 4; ++i) *(LAS u32x4*)(vrow + 16 * i) = vv[i];
        f32x16 s;
#pragma unroll
        for (int i = 0; i < 16; ++i) s[i] = 0.f;
#pragma unroll
        for (int kk = 0; kk < 4; ++kk) s = __builtin_amdgcn_mfma_f32_32x32x16_bf16(kf[kk], qf[kk], s, 0, 0, 0);
        const bool diag = (kb == q0);
        float rr[16], be[16];
#pragma unroll
        for (int i = 0; i < 16; ++i) { const int key = (i & 3) + 8 * (i >> 2) + 4 * hi; const float z = fminf(s[i], 80.f); const float e = fexp2(z * 1.44269504f); const float ri = frcp(1.f + e);
            const bool masked = diag && (key >= r); rr[i] = masked ? 1.f : ri; be[i] = masked ? 0.f : e * ri; }
        float t[4], p[4], pp[4];
#pragma unroll
        for (int g = 0; g < 4; ++g) { t[g] = (rr[4 * g] * rr[4 * g + 1]) * (rr[4 * g + 2] * rr[4 * g + 3]); { const unsigned ti_ = __builtin_bit_cast(unsigned, t[g]); const auto sw_ = __builtin_amdgcn_permlane32_swap(ti_, ti_, false, false);
              p[g] = __builtin_bit_cast(float, hi ? sw_[0] : sw_[1]); } pp[g] = t[g] * p[g]; }
        float Sx[4]; Sx[3] = 1.f; Sx[2] = pp[3]; Sx[1] = Sx[2] * pp[2]; Sx[0] = Sx[1] * pp[1];
        const float tot = Sx[0] * pp[0];
        float a[16];
#pragma unroll
        for (int g = 0; g < 4; ++g) { float E = P * Sx[g] * (hi == 0 ? p[g] : 1.f);
            a[4 * g + 3] = be[4 * g + 3] * E; E *= rr[4 * g + 3]; a[4 * g + 2] = be[4 * g + 2] * E; E *= rr[4 * g + 2]; a[4 * g + 1] = be[4 * g + 1] * E; E *= rr[4 * g + 1]; a[4 * g] = be[4 * g] * E; }
        P *= tot;
#pragma unroll
        for (int s2 = 0; s2 < 2; ++s2) {
            u32x4 ap; ap.x = pk2(a[8 * s2], a[8 * s2 + 1]); ap.y = pk2(a[8 * s2 + 2], a[8 * s2 + 3]); ap.z = pk2(a[8 * s2 + 4], a[8 * s2 + 5]); ap.w = pk2(a[8 * s2 + 6], a[8 * s2 + 7]);
            const bf16x8 af = __builtin_bit_cast(bf16x8, ap);
#pragma unroll
            for (int db = 0; db < 2; ++db) { bf16x8 vf;
#pragma unroll
                for (int j = 0; j < 8; ++j) { const int key = 16 * s2 + 8 * (j >> 2) + 4 * hi + (j & 3); vf[j] = *(const LAS short*)(vl + key * 144 + (db * 32 + r) * 2); }
                if (db == 0) o0 = __builtin_amdgcn_mfma_f32_32x32x16_bf16(vf, af, o0, 0, 0, 0); else o1 = __builtin_amdgcn_mfma_f32_32x32x16_bf16(vf, af, o1, 0, 0, 0); }
        }
        if (__all(P < 1e-12f)) break;
    }
    unsigned char* op = MIX + (tok0 + q0 + r) * DM + h * 64 + 4 * hi;
#pragma unroll
    for (int g = 0; g < 4; ++g) { int t0 = __builtin_amdgcn_cvt_pk_fp8_f32(o0[4 * g], o0[4 * g + 1], 0, false); t0 = __builtin_amdgcn_cvt_pk_fp8_f32(o0[4 * g + 2], o0[4 * g + 3], t0, true);
        int t1 = __builtin_amdgcn_cvt_pk_fp8_f32(o1[4 * g], o1[4 * g + 1], 0, false); t1 = __builtin_amdgcn_cvt_pk_fp8_f32(o1[4 * g + 2], o1[4 * g + 3], t1, true);
        *(int*)(op + 8 * g) = t0; *(int*)(op + 32 + 8 * g) = t1; }
}
__device__ __forceinline__ void conv_chunk(const bf16* U, unsigned char* MIX, const LAS float* wl, int tc, int bstart, const float* dwbp, const float* lngp, const float* lnbp, int lane) {
    f32x4 acc[8][2];
    { const f32x4 b0 = *(const f32x4*)(dwbp + 8 * lane), b1 = *(const f32x4*)(dwbp + 8 * lane + 4);
#pragma unroll
      for (int o = 0; o < 8; ++o) { acc[o][0] = b0; acc[o][1] = b1; } }
    f32x4 W[12][2]; u32x4 raw[12];
    const char* Ub = (const char*)U; const unsigned lo16 = 16u * (unsigned)lane;
#define CONV_LD(dst, I) do { const int s_ = tc - 30 + (I); int sc_ = s_ < bstart ? bstart : s_; sc_ = sc_ > NTOK - 1 ? NTOK - 1 : sc_; const u32x4 v_ = *(const u32x4*)(Ub + ((unsigned)sc_ * 1024u + lo16)); \
        dst = (s_ >= bstart) ? v_ : (u32x4){0u, 0u, 0u, 0u}; } while (0)
#define CONV_UNPACK(src, SLOT) do { W[SLOT][0] = (f32x4){bflo(src.x), bfhi(src.x), bflo(src.y), bfhi(src.y)}; W[SLOT][1] = (f32x4){bflo(src.z), bfhi(src.z), bflo(src.w), bfhi(src.w)}; } while (0)
#pragma unroll
    for (int q = 0; q < 11; ++q) CONV_LD(raw[q], q);
#pragma unroll
    for (int q = 0; q < 11; ++q) CONV_UNPACK(raw[q], q);
#pragma unroll
    for (int q = 0; q < 4; ++q) CONV_LD(raw[4 + q], 11 + q);
    __builtin_amdgcn_sched_barrier(0);
#pragma unroll 1
    for (int S = 0; S < 3; ++S) {
#pragma unroll
        for (int gq = 0; gq < 3; ++gq) { const int G = 3 * S + gq;
            if (G <= 7) {
                if (G >= 1) {
#pragma unroll
                    for (int q = 0; q < 4; ++q) CONV_UNPACK(raw[4 * gq + q], (4 * gq + 7 + q) % 12); }
                if (G <= 5) {
#pragma unroll
                    for (int q = 0; q < 4; ++q) CONV_LD(raw[4 * ((gq + 2) % 3) + q], 12 * S + 4 * gq + 15 + q); }
#pragma unroll
                for (int jj = 0; jj < 4; ++jj) { const int j = 12 * S + 4 * gq + jj; if (j <= 30) { const LAS f32x4* wp = (const LAS f32x4*)(wl + j * 512 + 8 * lane); const f32x4 w0 = wp[0], w1 = wp[1];
#pragma unroll
                    for (int o = 0; o < 8; ++o) { acc[o][0] += w0 * W[(4 * gq + jj + o) % 12][0]; acc[o][1] += w1 * W[(4 * gq + jj + o) % 12][1]; } }
                    if (jj == 1) __builtin_amdgcn_sched_barrier(0); }
            }
            __builtin_amdgcn_sched_barrier(0);
        }
    }
#undef CONV_LD
#undef CONV_UNPACK
    f32x4 lng[2], lnb[2]; lng[0] = *(const f32x4*)(lngp + 8 * lane); lng[1] = *(const f32x4*)(lngp + 8 * lane + 4); lnb[0] = *(const f32x4*)(lnbp + 8 * lane); lnb[1] = *(const f32x4*)(lnbp + 8 * lane + 4);
#pragma unroll
    for (int o = 0; o < 8; ++o) {
        const f32x4 a0 = acc[o][0], a1 = acc[o][1];
        const float mean = wave_sum((a0[0] + a0[1]) + (a0[2] + a0[3]) + (a1[0] + a1[1]) + (a1[2] + a1[3])) * (1.f / 512.f);
        const f32x4 d0 = a0 - mean, d1 = a1 - mean;
        const float var = wave_sum((d0[0] * d0[0] + d0[1] * d0[1]) + (d0[2] * d0[2] + d0[3] * d0[3]) + (d1[0] * d1[0] + d1[1] * d1[1]) + (d1[2] * d1[2] + d1[3] * d1[3])) * (1.f / 512.f);
        const float rstd = __builtin_amdgcn_rsqf(var + EPS);
        f32x4 y0 = d0 * rstd * lng[0] + lnb[0], y1 = d1 * rstd * lng[1] + lnb[1];
#pragma unroll
        for (int e = 0; e < 4; ++e) { y0[e] = y0[e] * sigmoidf_(y0[e]); y1[e] = y1[e] * sigmoidf_(y1[e]); }
        { u32x2 w; int t_ = __builtin_amdgcn_cvt_pk_fp8_f32(y0[0], y0[1], 0, false); w.x = (unsigned)__builtin_amdgcn_cvt_pk_fp8_f32(y0[2], y0[3], t_, true);
          t_ = __builtin_amdgcn_cvt_pk_fp8_f32(y1[0], y1[1], 0, false); w.y = (unsigned)__builtin_amdgcn_cvt_pk_fp8_f32(y1[2], y1[3], t_, true);
          *(u32x2*)(MIX + (size_t)(tc + o) * DM + 512 + 8 * lane) = w; }
    }
}
__device__ __forceinline__ void even_core(const Ctx& C, int l) {
    const int i = l >> 1; const int gw = C.vcu * NWAVES + C.wave, NGW = C.G * NWAVES;
    LAS float* wl = (LAS float*)(C.lds + 40960);
    { const GAS f32x4* src = (const GAS f32x4*)(VEC(V_DWW) + (size_t)i * 31 * 512); f32x4 tv[8];
#pragma unroll
      for (int q = 0; q < 8; ++q) { const int idx = C.tid + NWAVES * 64 * q; tv[q] = src[idx < 3968 ? idx : 3967]; }
#pragma unroll
      for (int q = 0; q < 8; ++q) { const int idx = C.tid + NWAVES * 64 * q; if (idx < 3968) ((LAS f32x4*)wl)[idx] = tv[q]; } }
    __syncthreads();
    const bf16* QKV = WSB(WS_QKV); unsigned char* MIX = C.ws + WS_MIX;
    LAS unsigned char* vl = C.lds + C.wave * 4608;
    for (int u = gw; u < 64 * 128; u += NGW) { const int bh = u >> 7, qb = u & 127; attn_wave_unit(QKV, MIX, bh >> 3, bh & 7, qb, vl, C.lane); }
    for (int u = gw; u < NTOK / 16; u += NGW) { const int t0 = u * 16, bstart = t0 & ~(SEQ - 1);
#pragma unroll 1
        for (int ch = 0; ch < 2; ++ch) conv_chunk(WSB(WS_UE), MIX, wl, t0 + 8 * ch, bstart, VEC(V_DWB) + i * 512, VEC(V_LNG) + i * 512, VEC(V_LNB) + i * 512, C.lane); }
}
__device__ __forceinline__ void odd_core(const Ctx& C) {
    const int gw = C.vcu * NWAVES + C.wave, NGW = C.G * NWAVES, lane = C.lane;
    const bf16* U = WSB(WS_UO); unsigned char* PO = C.ws + WS_POOL;
    const int w = 2 << (lane >> 4);
    for (int u = gw; u < NTOK / 16; u += NGW) {
        const int t0 = u * 16, bstart = t0 & ~(SEQ - 1);
        float S[16];
#pragma unroll
        for (int e = 0; e < 16; ++e) S[e] = 0.f;
#pragma unroll
        for (int j = 1; j < 16; ++j) { const int s = t0 - j; const bool ok = (j < w) && (s >= bstart); const int sc = s < bstart ? bstart : s;
            const u32x4 v0 = *(const u32x4*)(U + (size_t)sc * DM + 16 * lane), v1 = *(const u32x4*)(U + (size_t)sc * DM + 16 * lane + 8); const float f = ok ? 1.f : 0.f;
            S[0] += f * bflo(v0.x); S[1] += f * bfhi(v0.x); S[2] += f * bflo(v0.y); S[3] += f * bfhi(v0.y); S[4] += f * bflo(v0.z); S[5] += f * bfhi(v0.z); S[6] += f * bflo(v0.w); S[7] += f * bfhi(v0.w);
            S[8] += f * bflo(v1.x); S[9] += f * bfhi(v1.x); S[10] += f * bflo(v1.y); S[11] += f * bfhi(v1.y); S[12] += f * bflo(v1.z); S[13] += f * bfhi(v1.z); S[14] += f * bflo(v1.w); S[15] += f * bfhi(v1.w); }
#pragma unroll 4
        for (int i = 0; i < 16; ++i) { const int t = t0 + i;
            const u32x4 v0 = *(const u32x4*)(U + (size_t)t * DM + 16 * lane), v1 = *(const u32x4*)(U + (size_t)t * DM + 16 * lane + 8);
            float c[16] = {bflo(v0.x), bfhi(v0.x), bflo(v0.y), bfhi(v0.y), bflo(v0.z), bfhi(v0.z), bflo(v0.w), bfhi(v0.w), bflo(v1.x), bfhi(v1.x), bflo(v1.y), bfhi(v1.y), bflo(v1.z), bfhi(v1.z), bflo(v1.w), bfhi(v1.w)};
            const int n = t - bstart + 1; const float inv = 1.f / (float)(n < w ? n : w);
            float o[16];
#pragma unroll
            for (int e = 0; e < 16; ++e) { S[e] += c[e]; o[e] = S[e] * inv - c[e]; }
            u32x4 w0;
#pragma unroll
            for (int q = 0; q < 4; ++q) { int t_ = __builtin_amdgcn_cvt_pk_fp8_f32(o[4 * q], o[4 * q + 1], 0, false); w0[q] = (unsigned)__builtin_amdgcn_cvt_pk_fp8_f32(o[4 * q + 2], o[4 * q + 3], t_, true); }
            *(u32x4*)(PO + (size_t)t * DM + 16 * lane) = w0;
            const int old = t - w + 1; const bool ok = old >= bstart; const int oc = ok ? old : bstart; const float f = ok ? 1.f : 0.f;
            const u32x4 q0 = *(const u32x4*)(U + (size_t)oc * DM + 16 * lane), q1 = *(const u32x4*)(U + (size_t)oc * DM + 16 * lane + 8);
            S[0] -= f * bflo(q0.x); S[1] -= f * bfhi(q0.x); S[2] -= f * bflo(q0.y); S[3] -= f * bfhi(q0.y); S[4] -= f * bflo(q0.z); S[5] -= f * bfhi(q0.z); S[6] -= f * bflo(q0.w); S[7] -= f * bfhi(q0.w);
            S[8] -= f * bflo(q1.x); S[9] -= f * bfhi(q1.x); S[10] -= f * bflo(q1.y); S[11] -= f * bfhi(q1.y); S[12] -= f * bflo(q1.z); S[13] -= f * bfhi(q1.z); S[14] -= f * bflo(q1.w); S[15] -= f * bfhi(q1.w); }
    }
}

struct Args { const float* in[25]; float* out; unsigned char* ws; int ph_lo, ph_hi; };
__global__ void __launch_bounds__(NWAVES * 64, 2) fwd(Args args) {
    extern __shared__ __attribute__((aligned(16))) unsigned char lds_raw[];
    Ctx C0;
#define C C0
    C.lds = (LAS unsigned char*)lds_raw; C.tab = (LAS int*)(C.lds + TAB_OFF);
    C.tid = threadIdx.x; C.lane = C.tid & 63; C.wave = __builtin_amdgcn_readfirstlane(C.tid >> 6);
    C.G = gridDim.x; { const int bx = blockIdx.x; C.vcu = (C.G % 8 == 0) ? (bx % 8) * (C.G / 8) + bx / 8 : bx; }
    C.xin = args.in[0]; C.w1 = args.in[18]; C.w3 = args.in[19]; C.w2 = args.in[20];
    C.X = args.out; C.ws = args.ws;
    volatile LAS unsigned* MISC = (volatile LAS unsigned*)(C.lds + MISC_OFF);
    for (int u = C.tid; u < (LDS_BYTES - TAB_OFF) / 4; u += NWAVES * 64) ((LAS unsigned*)(C.lds + TAB_OFF))[u] = 0u;
    __syncthreads();
    const int lo = args.ph_lo, hi = args.ph_hi;
    unsigned* barw = (unsigned*)(C0.ws + WS_CTL) + CW_BAR;
    XcdBarrier bar; bar.bar = barw; bar.x = 0; bar.st = nullptr;
    if (hi - lo > 1) bar = xcd_barrier_post(barw, MISC + 8);
#undef C
#define IN(k) (lo <= (k) && (k) < hi)
#define SEAM(k) do { if (IN(k) && IN((k) + 1)) xcd_barrier(bar); } while (0)

    if (IN(0)) { const Ctx C = phase_ctx(C0); prologue(C, args); }
    SEAM(0);
#pragma unroll 1
    for (int l = 0; l < DEPTH; ++l) {
        const int pb = 1 + 7 * l, i2 = l >> 1; const bool even = (l & 1) == 0;
        if (IN(pb)) { const Ctx C = phase_ctx(C0); if (l == 0) row_phase<0>(C, l); else combine_phase<false>(C, l); }
        SEAM(pb);
        if (IN(pb + 1)) { const Ctx C = phase_ctx(C0);
            if (even) { pg8::DenseSched S; S.A = (const char*)(C.ws + WS_H); S.Bt = (const char*)(C.ws + WS_WINE) + (size_t)i2 * 2560 * 1024; S.Kb = 1024; S.so.init(NTOK, 2560, C.G, (int)blockIdx.x);
                pg8::EpiEven E{WSB(WS_QKV), WSB(WS_UE)}; pg8::gemm_phase<pg8::EpiEven, pg8::DenseSched, false, true, pg8::FP8_SCALE_G1>(C.lds, 1024, S, E); }
            else { pg8::DenseSched S; S.A = (const char*)(C.ws + WS_H); S.Bt = (const char*)(C.ws + WS_WINO) + (size_t)i2 * 1024 * 1024; S.Kb = 1024; S.so.init(NTOK, 1024, C.G, (int)blockIdx.x);
                pg8::EpiStore E{WSB(WS_UO), 1024, WSB(WS_UO), 1024}; pg8::gemm_phase<pg8::EpiStore, pg8::DenseSched, false, true, pg8::FP8_SCALE_G1>(C.lds, 1024, S, E); }
        }
        SEAM(pb + 1);
        if (IN(pb + 2)) { const Ctx C = phase_ctx(C0);
            if (even) even_core(C, l); else odd_core(C);
            if (l > 0) { __syncthreads(); moe_convert(C, l, (LAS float*)(C.lds + C.wave * 8448), C.vcu * NWAVES + C.wave, C.G * NWAVES); }
        }
        SEAM(pb + 2);
        if (IN(pb + 3)) { const Ctx C = phase_ctx(C0);
            pg8::DenseSched S; S.A = (const char*)(C.ws + (even ? WS_MIX : WS_POOL)); S.Bt = (const char*)(C.ws + (even ? WS_WOUTE : WS_WC)) + (size_t)i2 * 1024 * 1024; S.Kb = 1024; S.so.init(NTOK, 1024, C.G, (int)blockIdx.x);
            pg8::EpiResid E{WSB(WS_X), (const float*)(C.ws + WS_MOD) + (size_t)l * 8 * 6144 + 2 * 1024}; pg8::gemm_phase<pg8::EpiResid, pg8::DenseSched, false, true, pg8::FP8_SCALE_G1>(C.lds, 1024, S, E);
        }
        SEAM(pb + 3);
        if (IN(pb + 4)) { const Ctx C = phase_ctx(C0); row_phase<2>(C, l); }
        SEAM(pb + 4);
        if (IN(pb + 5)) { const Ctx C = phase_ctx(C0);
            build_tables(C, l);
            pg8::MoeSched S; S.tab = C.tab; S.T = C.tab[64]; S.nsplit = 2; S.nshared = 256; S.G = C.G; S.c = C.vcu; S.Kb = 1024; S.gemm1 = 1;
            S.Ash = (const char*)(C.ws + WS_H8); S.Art = S.Ash; S.Bsh = (const char*)(C.ws + WS_WS13) + (size_t)l * 512 * 1024; S.Brt = (const char*)(C.ws + WS_W13) + (size_t)(l & 1) * (32 * MiB);
            S.bstride_e = (size_t)512 * 1024; S.bstride_n = (size_t)256 * 1024; S.tokof = (const int*)(C.ws + WS_TOKOF);
            pg8::EpiSwiGLU E{C.ws + WS_HR, C.ws + WS_HS}; pg8::gemm_phase<pg8::EpiSwiGLU, pg8::MoeSched, true, true, pg8::FP8_SCALE_G1>(C.lds, 1024, S, E);
        }
        SEAM(pb + 5);
        if (IN(pb + 6)) { const Ctx C = phase_ctx(C0);
#if MK_PER_PHASE
            build_tables(C, l);
#endif
            pg8::MoeSched S; S.tab = C.tab; S.T = C.tab[64]; S.nsplit = 4; S.nshared = 512; S.G = C.G; S.c = C.vcu; S.Kb = 256; S.gemm1 = 0;
            S.Ash = (const char*)(C.ws + WS_HS); S.Art = (const char*)(C.ws + WS_HR); S.Bsh = (const char*)(C.ws + WS_WS2) + (size_t)l * 1024 * 256; S.Brt = (const char*)(C.ws + WS_W2) + (size_t)(l & 1) * (16 * MiB);
            S.bstride_e = (size_t)1024 * 256; S.bstride_n = (size_t)256 * 256; S.tokof = nullptr;
            pg8::EpiPair E{C.ws + WS_PAIR, C.ws + WS_SOUT}; pg8::gemm_phase<pg8::EpiPair, pg8::MoeSched, false, true, pg8::FP8_SCALE_G2>(C.lds, 256, S, E);
        }
        SEAM(pb + 6);
    }
    if (IN(29)) { const Ctx C = phase_ctx(C0); combine_phase<true>(C, DEPTH); }
#undef IN
#undef SEAM
}

extern "C" void kernel_launch(void* const* d_in, const int* in_sizes, int n_in, void* d_out, int out_size, void* d_ws, size_t ws_size, hipStream_t stream) {
    static int grid = 0;
    if (grid == 0) {
        if (n_in != 25 || out_size != NTOK * DM || ws_size < WS_END) { fprintf(stderr, "kernel_launch: unexpected shapes (n_in %d, out %d, ws %zu < %zu); nothing launched\n", n_in, out_size, ws_size, (size_t)WS_END); grid = -1; return; }
        int dev = 0, cus = 0, per_cu = 0;
        if (hipGetDevice(&dev) != hipSuccess || hipDeviceGetAttribute(&cus, hipDeviceAttributeMultiprocessorCount, dev) != hipSuccess) { grid = -1; return; }
        if (hipFuncSetAttribute((const void*)fwd, hipFuncAttributeMaxDynamicSharedMemorySize, LDS_BYTES) != hipSuccess) { fprintf(stderr, "kernel_launch: hipFuncSetAttribute failed\n"); grid = -1; return; }
        if (hipOccupancyMaxActiveBlocksPerMultiprocessor(&per_cu, (const void*)fwd, NWAVES * 64, LDS_BYTES) != hipSuccess || per_cu < 1) fprintf(stderr, "kernel_launch: note: occupancy query reports %d\n", per_cu);
        (void)hipGetLastError();
        grid = cus;
        if (grid != 256) fprintf(stderr, "kernel_launch: note: %d CUs (tuned for 256)\n", grid);
    }
    if (grid < 0) return;
    if (hipMemsetAsync((char*)d_ws + WS_CTL, 0, CTL_ZERO_BYTES, stream) != hipSuccess) { fprintf(stderr, "kernel_launch: memset failed\n"); return; }
    Args a{};
    for (int i = 0; i < 25; ++i) a.in[i] = (const float*)d_in[i];
    a.out = (float*)d_out; a.ws = (unsigned char*)d_ws;
#if MK_PER_PHASE
    for (int p = 0; p < NPHASE; ++p) { a.ph_lo = p; a.ph_hi = p + 1; hipLaunchKernelGGL(fwd, dim3(grid), dim3(NWAVES * 64), LDS_BYTES, stream, a); }
#else
    a.ph_lo = 0; a.ph_hi = NPHASE; hipLaunchKernelGGL(fwd, dim3(grid), dim3(NWAVES * 64), LDS_BYTES, stream, a);
#endif
    const hipError_t le = hipPeekAtLastError();
    if (le != hipSuccess) fprintf(stderr, "kernel_launch: launch failed: %s\n", hipGetErrorName(le));
}
```

```cpp
#include <hip/hip_runtime.h>
#include <cstdio>
#include <cstdint>

#ifndef MK_PER_PHASE
#define MK_PER_PHASE 0
#endif

#define LAS __attribute__((address_space(3)))
#define GAS __attribute__((address_space(1)))
typedef unsigned short bf16;
typedef short bf16x8 __attribute__((ext_vector_type(8)));
typedef float f32x2 __attribute__((ext_vector_type(2)));
typedef float f32x4 __attribute__((ext_vector_type(4)));
typedef float f32x16 __attribute__((ext_vector_type(16)));
typedef unsigned u32x2 __attribute__((ext_vector_type(2)));
typedef unsigned u32x4 __attribute__((ext_vector_type(4)));
typedef __bf16 bf16x2_t __attribute__((ext_vector_type(2)));
typedef GAS unsigned gu32;

#define LDS_WAIT() asm volatile("s_waitcnt lgkmcnt(0)" ::: "memory")
#define VM_WAIT() asm volatile("s_waitcnt vmcnt(0)" ::: "memory")
#define RLX_AGENT __ATOMIC_RELAXED, __HIP_MEMORY_SCOPE_AGENT

__device__ __forceinline__ unsigned pk2(float lo, float hi) { f32x2 v = {lo, hi}; bf16x2_t b = __builtin_convertvector(v, bf16x2_t); return __builtin_bit_cast(unsigned, b); }
__device__ __forceinline__ float bflo(unsigned u) { return __builtin_bit_cast(float, u << 16); }
__device__ __forceinline__ float bfhi(unsigned u) { return __builtin_bit_cast(float, u & 0xffff0000u); }
__device__ __forceinline__ float fexp2(float x) { return __builtin_amdgcn_exp2f(x); }
__device__ __forceinline__ float frcp(float x) { return __builtin_amdgcn_rcpf(x); }
__device__ __forceinline__ float sigmoidf_(float x) { return frcp(1.f + fexp2(-1.44269504f * x)); }
__device__ __forceinline__ float wave_sum(float v) {
#define WS_DPP(ctrl) v += __builtin_bit_cast(float, __builtin_amdgcn_update_dpp(0, __builtin_bit_cast(int, v), (ctrl), 0xf, 0xf, false))
    WS_DPP(0xB1); WS_DPP(0x4E); WS_DPP(0x141); WS_DPP(0x140);
#undef WS_DPP
    const int vi = __builtin_bit_cast(int, v);
    v = (__builtin_bit_cast(float, __builtin_amdgcn_readlane(vi, 0)) + __builtin_bit_cast(float, __builtin_amdgcn_readlane(vi, 16)))
      + (__builtin_bit_cast(float, __builtin_amdgcn_readlane(vi, 32)) + __builtin_bit_cast(float, __builtin_amdgcn_readlane(vi, 48)));
    return v;
}

namespace pg8 {
constexpr int BM = 256, BK = 64, HALF = 128, HTB = HALF * BK * 2, STAGE_BYTES = 8 * HTB, NXCD = 8, WGM = 8;
typedef int v4i __attribute__((ext_vector_type(4)));
typedef int v8i __attribute__((ext_vector_type(8)));
constexpr int FP8_SHIFT_G1 = 10, FP8_SCALE_G1 = 0x7A7A7A7A;
constexpr int FP8_SHIFT_G2 = 8, FP8_SCALE_G2 = 0x7B7B7B7B;
constexpr int FP8_UNUSED_ = 0;
__host__ __device__ __forceinline__ int lds_byte(int r, int c) { const int st = (r >> 4) * 2 + (c >> 5), rr = r & 15, cc = c & 31, ob = rr * 64 + cc * 2; return st * 1024 + (ob ^ (((ob >> 9) & 1) << 5)); }
__host__ __device__ __forceinline__ void stage_rc(int b, int& R, int& C) { const int st = b / 1024, sb = b % 1024, swz = sb ^ (((sb >> 9) & 1) << 5); R = (st >> 1) * 16 + swz / 64; C = (st & 1) * 32 + (swz % 64) / 2; }
__host__ __device__ __forceinline__ int perm32(int rho) { const int n = rho >> 4, i = rho & 15; return 8 * (i >> 2) + 4 * n + (i & 3); }

struct Unit { const char* pa; const char* pb; const int* list; int row0; int orow; int nvalid; int pn; int og; };

struct StaticMN {
    int nM, nN, nwg, G, c;
    __device__ void init(int M, int N, int G_, int c_) { nM = M / BM; nN = N / BM; nwg = nM * nN; G = G_; c = c_; }
    __device__ bool next(int i, int& pm, int& pn) const {
        const long L = (long)i * G + c; if (L >= nwg) return false;
        int wgid = (int)L; { const int q = nwg / NXCD, r = nwg % NXCD, xcd = wgid % NXCD, off = wgid / NXCD; wgid = (xcd < r ? xcd * (q + 1) : r * (q + 1) + (xcd - r) * q) + off; }
        const int nig = WGM * nN, gid = wgid / nig, fm = gid * WGM, gsz = (nM - fm) < WGM ? (nM - fm) : WGM;
        pm = fm + ((wgid % nig) % gsz); pn = (wgid % nig) / gsz; return true;
    }
};

__device__ __forceinline__ void glds16s(const char* base, unsigned voff, unsigned lds_dst) { unsigned keep;
    asm volatile("s_mov_b32 %0, m0\n\ts_mov_b32 m0, %2\n\ts_nop 0\n\tglobal_load_lds_dwordx4 %1, %3\n\ts_mov_b32 m0, %0" : "=&s"(keep) : "v"(voff), "s"(lds_dst), "s"(base) : "memory"); }
template <class Epi, class Sched, bool GATHER, bool FP8 = false, int FP8_SCALE = 0x7F7F7F7F, bool ALIGN = true, bool ASHARE = false>
__device__ __forceinline__ void gemm_phase(LAS unsigned char* lds, const int Kb  , const Sched& S, const Epi& E) {
    int tid; asm volatile("v_mov_b32 %0, %1" : "=v"(tid) : "v"((int)threadIdx.x));
    const int wid = __builtin_amdgcn_readfirstlane(tid >> 6), lane = tid & 63, wr = wid >> 2, wc = wid & 3, fr = lane & 15, fq = lane >> 4;
    const int nt = Kb / 128;
    unsigned voffB[2];
#pragma unroll
    for (int i = 0; i < 2; ++i) { int R, C; stage_rc(tid * 16 + i * 8192, R, C); const int Rb = Epi::NCONT ? ((R >> 5) * 64 + perm32(R & 31)) : ((R & ~31) + perm32(R & 31));
        voffB[i] = (unsigned)(Rb * Kb + C * 2); }
    const size_t kstep = (size_t)(BK * 2);
    const size_t hstep = (size_t)(Epi::NCONT ? 32 : HALF) * Kb;
    const unsigned ldsb = (unsigned)__builtin_amdgcn_readfirstlane((int)((unsigned)(__UINTPTR_TYPE__)lds + (unsigned)wid * 1024u));
    const int aoff = lds_byte(wr * 64 + fr, fq * 8), boff = lds_byte(wc * 32 + fr, fq * 8);
#define PG8_SA(b, h) (((b) * 2 + (h)) * HTB)
#define PG8_SB(b, h) ((4 + (b) * 2 + (h)) * HTB)
#define PG8_STAGE_B(bufoff, gbase) do { _Pragma("unroll") for (int _i = 0; _i < 2; ++_i) glds16s((const char*)(gbase), voffB[_i], ldsb + (unsigned)((bufoff) + _i * 8192)); } while (0)
#define PG8_STAGE_A(bufoff, gbase, vv, h) do { _Pragma("unroll") for (int _i = 0; _i < 2; ++_i) glds16s((const char*)(gbase), (vv)[h][_i], ldsb + (unsigned)((bufoff) + _i * 8192)); } while (0)
#define PG8_ROWOFF(u, v) do { _Pragma("unroll") for (int _h = 0; _h < 2; ++_h) _Pragma("unroll") for (int _i = 0; _i < 2; ++_i) { int _R, _C; stage_rc(tid * 16 + _i * 8192, _R, _C); const int _r = _h * HALF + _R; int _t; \
        if (GATHER) { if ((u).list) _t = (u).list[_r < (u).nvalid ? _r : 0]; else _t = (u).row0 + _r; } else _t = _r; \
        (v)[_h][_i] = (unsigned)_t * (unsigned)Kb + (unsigned)_C * 2u; } } while (0)
#define PG8_ROWTOK(u, tk) do { _Pragma("unroll") for (int _h = 0; _h < 2; ++_h) _Pragma("unroll") for (int _i = 0; _i < 2; ++_i) { int _R, _C; stage_rc(tid * 16 + _i * 8192, _R, _C); const int _r = _h * HALF + _R; \
        if ((u).list) (tk)[_h][_i] = (unsigned)(u).list[_r < (u).nvalid ? _r : 0]; else (tk)[_h][_i] = (unsigned)((u).row0 + _r); } } while (0)
#define PG8_TOK2OFF(tk, v) do { _Pragma("unroll") for (int _h = 0; _h < 2; ++_h) _Pragma("unroll") for (int _i = 0; _i < 2; ++_i) { int _R, _C; stage_rc(tid * 16 + _i * 8192, _R, _C); \
        (v)[_h][_i] = (unsigned)(tk)[_h][_i] * (unsigned)Kb + (unsigned)_C * 2u; } } while (0)
#define PG8_LDA(dst, b, h) do { _Pragma("unroll") for (int m = 0; m < 4; ++m) _Pragma("unroll") for (int k = 0; k < 2; ++k) dst[m][k] = *(const LAS bf16x8*)(lds + PG8_SA(b, h) + aoff + m * 2048 + k * 1024); } while (0)
#define PG8_LDB(dst, b, h) do { _Pragma("unroll") for (int n = 0; n < 2; ++n) _Pragma("unroll") for (int k = 0; k < 2; ++k) dst[n][k] = *(const LAS bf16x8*)(lds + PG8_SB(b, h) + boff + n * 2048 + k * 1024); } while (0)
#define PG8_CAT(x0, x1) __builtin_shufflevector(__builtin_bit_cast(v4i, x0), __builtin_bit_cast(v4i, x1), 0, 1, 2, 3, 4, 5, 6, 7)
#define PG8_MMA(ai, bj, At, Bt, zc) do { __builtin_amdgcn_s_setprio(1); \
        if (FP8) { const v8i b8_0 = PG8_CAT(Bt[0][0], Bt[0][1]), b8_1 = PG8_CAT(Bt[1][0], Bt[1][1]); \
            if (zc) {     \
              _Pragma("unroll") for (int m = 0; m < 4; ++m) { const v8i a8 = PG8_CAT(At[m][0], At[m][1]); \
                asm volatile("v_mfma_scale_f32_16x16x128_f8f6f4 %0, %1, %2, 0, %3, %4 op_sel_hi:[0,0,0]" : "=&v"(acc[ai][bj][m][0]) : "v"(b8_0), "v"(a8), "v"(scw), "v"(scw)); \
                asm volatile("v_mfma_scale_f32_16x16x128_f8f6f4 %0, %1, %2, 0, %3, %4 op_sel_hi:[0,0,0]" : "=&v"(acc[ai][bj][m][1]) : "v"(b8_1), "v"(a8), "v"(scw), "v"(scw)); } } \
            else { \
              _Pragma("unroll") for (int m = 0; m < 4; ++m) { const v8i a8 = PG8_CAT(At[m][0], At[m][1]); \
                asm volatile("v_mfma_scale_f32_16x16x128_f8f6f4 %0, %1, %2, %0, %3, %4 op_sel_hi:[0,0,0]" : "+v"(acc[ai][bj][m][0]) : "v"(b8_0), "v"(a8), "v"(scw), "v"(scw)); \
                asm volatile("v_mfma_scale_f32_16x16x128_f8f6f4 %0, %1, %2, %0, %3, %4 op_sel_hi:[0,0,0]" : "+v"(acc[ai][bj][m][1]) : "v"(b8_1), "v"(a8), "v"(scw), "v"(scw)); } } } \
        else { _Pragma("unroll") for (int m = 0; m < 4; ++m) _Pragma("unroll") for (int n = 0; n < 2; ++n) _Pragma("unroll") for (int k = 0; k < 2; ++k) \
            acc[ai][bj][m][n] = __builtin_amdgcn_mfma_f32_16x16x32_bf16(Bt[n][k], At[m][k], acc[ai][bj][m][n], 0, 0, 0); } __builtin_amdgcn_s_setprio(0); } while (0)
#define PG8_WAIT_V(n) asm volatile("s_waitcnt vmcnt(" #n ")" ::: "memory")
#define PG8_WAIT_L(n) asm volatile("s_waitcnt lgkmcnt(" #n ")" ::: "memory")
#define PG8_WAIT_K(k, rx) do { if constexpr (ASHARE) { const int w_ = wk[k]; if (w_ >= 16) PG8_WAIT_V(16); else if (w_ >= 14) PG8_WAIT_V(14); else if (w_ >= 12) PG8_WAIT_V(12); else if (w_ >= 8) PG8_WAIT_V(8); \
            else if (w_ >= 6) PG8_WAIT_V(6); else PG8_WAIT_V(4); } else { if ((k) < 3) PG8_WAIT_VF(rx); else PG8_WAIT_V(8); } } while (0)
#define PG8_WAIT_VF(rx) do { if (rx) { if (Epi::NVM >= 32) PG8_WAIT_V(40); else if (Epi::NVM >= 16) PG8_WAIT_V(24); else if (Epi::NVM >= 8) PG8_WAIT_V(16); else if (Epi::NVM >= 4) PG8_WAIT_V(12); else PG8_WAIT_V(8); } else PG8_WAIT_V(8); } while (0)
#define PG8_BAR __builtin_amdgcn_s_barrier()
#define PG8_SCHED __builtin_amdgcn_sched_barrier(0)
    Unit cur, nxt; int ui = 0;
    if (!S.next(0, cur)) return;
    f32x4 acc[2][2][4][2];
#pragma unroll
    for (int a = 0; a < 2; ++a)
#pragma unroll
        for (int b = 0; b < 2; ++b)
#pragma unroll
            for (int m = 0; m < 4; ++m)
#pragma unroll
                for (int n = 0; n < 2; ++n) acc[a][b][m][n] = (f32x4){0.f, 0.f, 0.f, 0.f};
    bf16x8 At[4][2], B0[2][2], B1[2][2];
    const int scw = FP8_SCALE;
    unsigned vA[2][2], vN[2][2];
    PG8_ROWOFF(cur, vA);
    const char* cA = cur.pa; const char* cB = cur.pb;
    PG8_STAGE_B(PG8_SB(0, 0), cB); PG8_STAGE_B(PG8_SB(0, 1), cB + hstep); PG8_STAGE_A(PG8_SA(0, 0), cA, vA, 0); PG8_STAGE_A(PG8_SA(0, 1), cA, vA, 1);
    if (wr == 1) PG8_BAR;
    PG8_WAIT_V(2); PG8_BAR;
    PG8_STAGE_B(PG8_SB(1, 0), cB + kstep); PG8_STAGE_A(PG8_SA(1, 0), cA + kstep, vA, 0); PG8_STAGE_B(PG8_SB(1, 1), cB + hstep + kstep);
    if (Epi::HOIST) { PG8_STAGE_A(PG8_SA(1, 1), cA + kstep, vA, 1); PG8_WAIT_V(8); } else PG8_WAIT_V(6);
    PG8_BAR;
    for (;;) {
        const bool has_next = S.next(ui + 1, nxt);
        const char* nA = has_next ? nxt.pa : cA; const char* nB = has_next ? nxt.pb : cB;
        if (GATHER && has_next) { PG8_ROWTOK(nxt, vN); }
        else {
#pragma unroll
            for (int h = 0; h < 2; ++h)
#pragma unroll
                for (int i = 0; i < 2; ++i) vN[h][i] = vA[h][i]; }
        bool stAn = true; int wk[4] = {8, 8, 8, 8};
        if constexpr (ASHARE) { const int pn_ = cur.pn; stAn = pn_ == 3;
            if (ui == 0) { wk[0] = 8; wk[1] = 6; wk[2] = 4; wk[3] = 4; }
            else if (pn_ == 0) { wk[0] = 16; wk[1] = 14; wk[2] = 12; wk[3] = 4; }
            else if (pn_ == 3) { wk[0] = 12; wk[1] = 14; wk[2] = 16; wk[3] = 8; }
            else { wk[0] = 12; wk[1] = 12; wk[2] = 12; wk[3] = 4; } }
#define PG8_TRIP(a1, a2, b2, w2, zc, fst) do { const char* a3 = (a2) + kstep; const char* b3 = (b2) + kstep; const bool relax_ = (fst) && ui > 0; \
              \
            PG8_LDB(B0, 0, 0); PG8_LDB(B1, 0, 1); PG8_SCHED; PG8_LDA(At, 0, 0); if (!ASHARE && !(fst)) PG8_STAGE_A(PG8_SA(1, 1), a1, vA, 1); \
            PG8_WAIT_K(0, relax_); PG8_WAIT_L(0); PG8_BAR; PG8_MMA(0, 0, At, B0, zc); PG8_MMA(0, 1, At, B1, zc); PG8_BAR; PG8_SCHED; \
              \
            PG8_LDA(At, 0, 1); PG8_STAGE_B(PG8_SB(0, 0), b2); PG8_STAGE_B(PG8_SB(0, 1), (b2) + hstep); if (stAn) PG8_STAGE_A(PG8_SA(0, 0), a2, w2, 0); \
            PG8_WAIT_K(1, relax_); PG8_WAIT_L(0); PG8_BAR; PG8_MMA(1, 0, At, B0, zc); PG8_MMA(1, 1, At, B1, zc); PG8_BAR; PG8_SCHED; \
              \
            PG8_LDB(B0, 1, 0); PG8_LDB(B1, 1, 1); PG8_SCHED; PG8_LDA(At, 1, 0); if (stAn) PG8_STAGE_A(PG8_SA(0, 1), a2, w2, 1); \
            PG8_WAIT_K(2, relax_); PG8_WAIT_L(0); PG8_BAR; PG8_MMA(0, 0, At, B0, false); PG8_MMA(0, 1, At, B1, false); PG8_BAR; PG8_SCHED; \
              \
            PG8_LDA(At, 1, 1); PG8_STAGE_B(PG8_SB(1, 0), b3); PG8_STAGE_B(PG8_SB(1, 1), b3 + hstep); if (stAn) PG8_STAGE_A(PG8_SA(1, 0), a3, w2, 0); \
            PG8_WAIT_K(3, false); PG8_WAIT_L(0); PG8_BAR; PG8_MMA(1, 0, At, B0, false); PG8_MMA(1, 1, At, B1, false); PG8_BAR; PG8_SCHED; } while (0)
        if (GATHER) {
#pragma unroll 1
            for (int t = 0; t < nt - 2; t += 2) { const char* a1 = cA + (size_t)(t + 1) * kstep; const char* a2 = cA + (size_t)(t + 2) * kstep; const char* b2 = cB + (size_t)(t + 2) * kstep; const bool zc = FP8 && t == 0, fst = Epi::HOIST && t == 0; PG8_TRIP(a1, a2, b2, vA, zc, fst); }
            { const char* a1 = cA + (size_t)(nt - 1) * kstep;
              if (has_next) { PG8_TOK2OFF(vN, vN); }
              const bool zc = FP8 && nt == 2, fst = Epi::HOIST && nt == 2; PG8_TRIP(a1, nA, nB, vN, zc, fst); }
        } else {
#pragma unroll 1
            for (int t = 0; t < nt; t += 2) { const bool last = (t == nt - 2); const char* a1 = cA + (size_t)(t + 1) * kstep;
                const char* a2 = last ? nA : cA + (size_t)(t + 2) * kstep; const char* b2 = last ? nB : cB + (size_t)(t + 2) * kstep; const bool zc = FP8 && t == 0, fst = Epi::HOIST && t == 0; PG8_TRIP(a1, a2, b2, vA, zc, fst); }
        }
#undef PG8_TRIP
        if (ALIGN && wr == 0) PG8_BAR;
        if (Epi::HOIST && has_next && (!ASHARE || cur.pn == 3)) PG8_STAGE_A(PG8_SA(1, 1), nA + kstep, vN, 1);
        if (FP8) { asm volatile("s_nop 15\n\ts_nop 15" ::: "memory");
#pragma unroll
            for (int a_ = 0; a_ < 2; ++a_)
#pragma unroll
                for (int b_ = 0; b_ < 2; ++b_) asm volatile("" : "+v"(acc[a_][b_][0][0]), "+v"(acc[a_][b_][0][1]), "+v"(acc[a_][b_][1][0]), "+v"(acc[a_][b_][1][1]), "+v"(acc[a_][b_][2][0]), "+v"(acc[a_][b_][2][1]), "+v"(acc[a_][b_][3][0]), "+v"(acc[a_][b_][3][1])); }
        E(acc, cur, wr, wc, fr, fq);
        if (!has_next) break;
        if (!FP8)
#pragma unroll
        for (int a = 0; a < 2; ++a)
#pragma unroll
            for (int b = 0; b < 2; ++b)
#pragma unroll
                for (int m = 0; m < 4; ++m)
#pragma unroll
                    for (int n = 0; n < 2; ++n) acc[a][b][m][n] = (f32x4){0.f, 0.f, 0.f, 0.f};
        cur = nxt; cA = nA; cB = nB; ++ui;
#pragma unroll
        for (int h = 0; h < 2; ++h)
#pragma unroll
            for (int i = 0; i < 2; ++i) vA[h][i] = vN[h][i];
        if (ALIGN && wr == 1) PG8_BAR;
    }
    if (!ALIGN && wr == 0) PG8_BAR;
    PG8_WAIT_V(0);
    PG8_BAR;
#undef PG8_SA
#undef PG8_SB
#undef PG8_STAGE_A
#undef PG8_STAGE_B
#undef PG8_ROWOFF
#undef PG8_ROWTOK
#undef PG8_TOK2OFF
#undef PG8_LDA
#undef PG8_LDB
#undef PG8_MMA
#undef PG8_CAT
#undef PG8_WAIT_V
#undef PG8_WAIT_L
#undef PG8_WAIT_VF
#undef PG8_WAIT_K
#undef PG8_BAR
#undef PG8_SCHED
}

__device__ __forceinline__ int xor16(int v, bool odd) { const auto sw = __builtin_amdgcn_permlane16_swap((unsigned)v, (unsigned)v, false, false); return (int)(odd ? sw[0] : sw[1]); }
__device__ __forceinline__ u32x4 pack8(const f32x4& v0, const f32x4& v1) { u32x4 w; w.x = pk2(v0[0], v0[1]); w.y = pk2(v0[2], v0[3]); w.z = pk2(v1[0], v1[1]); w.w = pk2(v1[2], v1[3]); return w; }

struct EpiStore {
    static constexpr bool HOIST = true; static constexpr int NVM = 16;
    static constexpr bool NCONT = true;
    bf16* O0; int ld0; bf16* O1; int ld1;
    __device__ __forceinline__ void operator()(const f32x4 (&acc)[2][2][4][2], const Unit& u, int wr, int wc, int fr, int fq) const {
        char* Ob = (char*)(u.og ? O1 : O0); const unsigned ldb = (unsigned)(u.og ? ld1 : ld0) * 2u;
        const unsigned cb = (unsigned)(u.pn * BM + wc * 64 + 8 * fq) * 2u; const int rl0 = wr * 64 + fr;
#pragma unroll
        for (int ai = 0; ai < 2; ++ai)
#pragma unroll
            for (int m = 0; m < 4; ++m) { const int rl = rl0 + ai * HALF + m * 16;
                { const unsigned off = (unsigned)(u.orow + rl) * ldb + cb;
#pragma unroll
                    for (int bj = 0; bj < 2; ++bj) *(u32x4*)(Ob + off + bj * 64) = pack8(acc[ai][bj][m][0], acc[ai][bj][m][1]); } }
    }
};
struct EpiResid {
    static constexpr bool NCONT = true;
    static constexpr bool HOIST = true; static constexpr int NVM = 32;
    bf16* X; const float* g1;
    __device__ __forceinline__ void operator()(const f32x4 (&acc)[2][2][4][2], const Unit& u, int wr, int wc, int fr, int fq) const {
        char* Xb = (char*)X; const int col0 = u.pn * BM + wc * 64 + 8 * fq; const int rl0 = wr * 64 + fr; const float* gp = g1 + (size_t)(u.orow >> 12) * 6144 + col0;
        f32x4 g[2][2];
#pragma unroll
        for (int bj = 0; bj < 2; ++bj) { g[bj][0] = *(const f32x4*)(gp + bj * 32); g[bj][1] = *(const f32x4*)(gp + bj * 32 + 4); }
#pragma unroll
        for (int ai = 0; ai < 2; ++ai) {
            u32x4 xr[4][2];
#pragma unroll
            for (int m = 0; m < 4; ++m)
#pragma unroll
                for (int bj = 0; bj < 2; ++bj) xr[m][bj] = *(const u32x4*)(Xb + (unsigned)(u.orow + rl0 + ai * HALF + m * 16) * 2048u + (unsigned)(col0 + bj * 32) * 2u);
#pragma unroll
            for (int m = 0; m < 4; ++m)
#pragma unroll
                for (int bj = 0; bj < 2; ++bj) { const u32x4 x = xr[m][bj]; const f32x4 a0 = acc[ai][bj][m][0], a1 = acc[ai][bj][m][1]; f32x4 v0, v1;
                    v0[0] = bflo(x.x) + g[bj][0][0] * a0[0]; v0[1] = bfhi(x.x) + g[bj][0][1] * a0[1]; v0[2] = bflo(x.y) + g[bj][0][2] * a0[2]; v0[3] = bfhi(x.y) + g[bj][0][3] * a0[3];
                    v1[0] = bflo(x.z) + g[bj][1][0] * a1[0]; v1[1] = bfhi(x.z) + g[bj][1][1] * a1[1]; v1[2] = bflo(x.w) + g[bj][1][2] * a1[2]; v1[3] = bfhi(x.w) + g[bj][1][3] * a1[3];
                    *(u32x4*)(Xb + (unsigned)(u.orow + rl0 + ai * HALF + m * 16) * 2048u + (unsigned)(col0 + bj * 32) * 2u) = pack8(v0, v1); }
            __builtin_amdgcn_sched_barrier(0); }
    }
};
struct EpiPair {
    static constexpr bool NCONT = true;
    static constexpr bool HOIST = true; static constexpr int NVM = 8;
    unsigned char* PAIR; unsigned char* SOUT8; unsigned char* DUMP;
    __device__ __forceinline__ void operator()(const f32x4 (&acc)[2][2][4][2], const Unit& u, int wr, int wc, int fr, int fq) const {
        const int rl0 = wr * 64 + fr; unsigned char* Ob = u.og ? SOUT8 : PAIR; const unsigned dump0 = (unsigned)(DUMP - Ob);
        { const bool odd = fq & 1;
            const unsigned cb16 = (unsigned)(u.pn * BM + wc * 64 + 8 * (fq & ~1) + (odd ? 32 : 0));
#pragma unroll
            for (int ai = 0; ai < 2; ++ai)
#pragma unroll
                for (int m = 0; m < 4; ++m) { const int rl = rl0 + ai * HALF + m * 16; int t[2][2];
#pragma unroll
                    for (int bj = 0; bj < 2; ++bj) { const f32x4 v0 = acc[ai][bj][m][0], v1 = acc[ai][bj][m][1];
                        int t0 = __builtin_amdgcn_cvt_pk_fp8_f32(v0[0], v0[1], 0, false); t0 = __builtin_amdgcn_cvt_pk_fp8_f32(v0[2], v0[3], t0, true);
                        int t1 = __builtin_amdgcn_cvt_pk_fp8_f32(v1[0], v1[1], 0, false); t1 = __builtin_amdgcn_cvt_pk_fp8_f32(v1[2], v1[3], t1, true); t[bj][0] = t0; t[bj][1] = t1; }
                    const int r0 = xor16(odd ? t[0][0] : t[1][0], odd), r1 = xor16(odd ? t[0][1] : t[1][1], odd);
                    u32x4 w; if (odd) { w.x = (unsigned)r0; w.y = (unsigned)r1; w.z = (unsigned)t[1][0]; w.w = (unsigned)t[1][1]; } else { w.x = (unsigned)t[0][0]; w.y = (unsigned)t[0][1]; w.z = (unsigned)r0; w.w = (unsigned)r1; }
                    const unsigned off = rl < u.nvalid ? (unsigned)(u.orow + rl) * 1024u + cb16 : dump0 + (unsigned)rl * 1024u + (cb16 & 1023u);
                    *(u32x4*)(Ob + off) = w; }
        }
    }
};
struct EpiEven {      static constexpr bool NCONT = true; static constexpr bool HOIST = true; static constexpr int NVM = 8;
    bf16* QKV; bf16* U;
    __device__ __forceinline__ void operator()(const f32x4 (&acc)[2][2][4][2], const Unit& u, int wr, int wc, int fr, int fq) const {
        const int rl0 = wr * 64 + fr;
        if (u.pn < 6) { const float sc = u.pn < 2 ? 0.125f : 1.f; char* Ob = (char*)QKV; const unsigned cb = (unsigned)(u.pn * BM + wc * 64 + 8 * fq) * 2u;
#pragma unroll
            for (int ai = 0; ai < 2; ++ai)
#pragma unroll
                for (int m = 0; m < 4; ++m) { const unsigned off = (unsigned)(u.orow + rl0 + ai * HALF + m * 16) * 3072u + cb;
#pragma unroll
                    for (int bj = 0; bj < 2; ++bj) { f32x4 v0 = acc[ai][bj][m][0] * sc, v1 = acc[ai][bj][m][1] * sc; *(u32x4*)(Ob + off + bj * 64) = pack8(v0, v1); } }
        } else { char* Ob = (char*)U; const unsigned cb = (unsigned)((u.pn - 6) * HALF + wc * 32 + 8 * fq) * 2u;
#pragma unroll
            for (int ai = 0; ai < 2; ++ai)
#pragma unroll
                for (int m = 0; m < 4; ++m) { f32x4 v0, v1;
#pragma unroll
                    for (int e = 0; e < 4; ++e) { v0[e] = acc[ai][0][m][0][e] * sigmoidf_(acc[ai][1][m][0][e]); v1[e] = acc[ai][0][m][1][e] * sigmoidf_(acc[ai][1][m][1][e]); }
                    *(u32x4*)(Ob + (unsigned)(u.orow + rl0 + ai * HALF + m * 16) * 1024u + cb) = pack8(v0, v1); }
        }
    }
};
struct EpiSwiGLU {    static constexpr bool NCONT = false; static constexpr bool HOIST = true; static constexpr int NVM = 4;
    unsigned char* HR; unsigned char* HS; unsigned char* DUMP;
    __device__ __forceinline__ void operator()(const f32x4 (&acc)[2][2][4][2], const Unit& u, int wr, int wc, int fr, int fq) const {
        unsigned char* Ob = u.og ? HS : HR; const unsigned dump0 = (unsigned)(DUMP - Ob); const bool odd = fq & 1; const unsigned cb = (unsigned)(u.pn * HALF + wc * 32 + 8 * (fq & ~1)); const int rl0 = wr * 64 + fr;
#pragma unroll
        for (int ai = 0; ai < 2; ++ai)
#pragma unroll
            for (int mp = 0; mp < 2; ++mp) { int t[2][2];
#pragma unroll
                for (int mm = 0; mm < 2; ++mm) { const int m = 2 * mp + mm; f32x4 v0, v1;
#pragma unroll
                    for (int e = 0; e < 4; ++e) { const float a0 = acc[ai][0][m][0][e], a1 = acc[ai][0][m][1][e];
                        v0[e] = a0 * sigmoidf_(a0) * acc[ai][1][m][0][e]; v1[e] = a1 * sigmoidf_(a1) * acc[ai][1][m][1][e]; }
                    int t0 = __builtin_amdgcn_cvt_pk_fp8_f32(v0[0], v0[1], 0, false); t0 = __builtin_amdgcn_cvt_pk_fp8_f32(v0[2], v0[3], t0, true);
                    int t1 = __builtin_amdgcn_cvt_pk_fp8_f32(v1[0], v1[1], 0, false); t1 = __builtin_amdgcn_cvt_pk_fp8_f32(v1[2], v1[3], t1, true); t[mm][0] = t0; t[mm][1] = t1; }
                const int r0 = xor16(odd ? t[0][0] : t[1][0], odd), r1 = xor16(odd ? t[0][1] : t[1][1], odd);
                u32x4 w; if (odd) { w.x = (unsigned)r0; w.y = (unsigned)r1; w.z = (unsigned)t[1][0]; w.w = (unsigned)t[1][1]; } else { w.x = (unsigned)t[0][0]; w.y = (unsigned)t[0][1]; w.z = (unsigned)r0; w.w = (unsigned)r1; }
                const int rl = rl0 + ai * HALF + (2 * mp + (odd ? 1 : 0)) * 16;
                const unsigned off = rl < u.nvalid ? (unsigned)(u.orow + rl) * 256u + cb : dump0 + (unsigned)rl * 256u + (cb & 255u);
                *(u32x4*)(Ob + off) = w; }
    }
};

struct DenseSched {
    const char* A; const char* Bt; int Kb; StaticMN so;
    __device__ __forceinline__ bool next(int i, Unit& u) const { int pm, pn; if (!so.next(i, pm, pn)) return false;
        u.pa = A + (size_t)pm * BM * Kb; u.pb = Bt + (size_t)pn * BM * Kb; u.list = nullptr; u.row0 = pm * BM; u.orow = pm * BM; u.nvalid = BM; u.pn = pn; u.og = 0; return true; }
};
struct MoeSched {
    const LAS int* tab; int T, nsplit, nshared, G, c, Kb, gemm1, ashare = 0;
    const char* Ash; const char* Art; const char* Bsh; const char* Brt; size_t bstride_e, bstride_n; const int* tokof;
    __device__ __forceinline__ bool next(int i, Unit& u) const {
        const int L = ashare ? ((i >> 2) * G + c) * 4 + (i & 3) : i * G + c; if (L >= nshared + T * nsplit) return false;
        if (L < nshared) { const int mt = L / nsplit, pn = L % nsplit; u.og = 1; u.orow = mt * BM; u.row0 = mt * BM; u.nvalid = BM; u.list = nullptr; u.pn = pn;
            u.pb = Bsh + (size_t)pn * bstride_n; u.pa = gemm1 ? Ash : Ash + (size_t)mt * BM * Kb; return true; }
        const int Lr = L - nshared, mt = Lr / nsplit, pn = Lr % nsplit;
        const int lo = (int)((const LAS unsigned short*)(tab + 512))[mt];
        const int e = __builtin_amdgcn_readfirstlane(lo), j = mt - __builtin_amdgcn_readfirstlane(tab[e]), ne = __builtin_amdgcn_readfirstlane(tab[160 + e]), cs = __builtin_amdgcn_readfirstlane(tab[80 + e]);
        const int nv = ne - j * BM; u.nvalid = nv < BM ? nv : BM; u.orow = cs + j * BM; u.row0 = 0; u.og = 0; u.pn = pn; u.pb = Brt + (size_t)e * bstride_e + (size_t)pn * bstride_n;
        if (gemm1) { u.list = tokof + (size_t)e * 32768 + j * BM; u.pa = Art; } else { u.list = nullptr; u.pa = Art + (size_t)(cs + j * BM) * Kb; }
        return true;
    }
};
}

constexpr int NTOK = 32768, DM = 1024, NBATCH = 8, SEQ = 4096, DEPTH = 4, NEXP = 64, TOPK = 8;
constexpr float EPS = 1e-6f;
constexpr int NWAVES = 8;
constexpr int NPHASE = 30;

constexpr size_t MiB = 1u << 20;
constexpr size_t WS_CTL = 0, CTL_ZERO_BYTES = 1 * MiB;
constexpr size_t WS_MOD = 1 * MiB;
constexpr size_t WS_PEP = 2 * MiB, WS_PW = 3 * MiB;
constexpr size_t WS_TOKOF = 4 * MiB;
constexpr size_t WS_WINE = 12 * MiB;
constexpr size_t WS_WOUTE = 22 * MiB;
constexpr size_t WS_WINO = 26 * MiB;
constexpr size_t WS_WC = 30 * MiB;
constexpr size_t WS_WR = 34 * MiB;
constexpr size_t WS_WS13 = 35 * MiB;
constexpr size_t WS_WS2 = 39 * MiB;
constexpr size_t WS_VEC = 42 * MiB;
constexpr size_t WS_W13 = 44 * MiB;
constexpr size_t WS_W2 = 108 * MiB;
constexpr size_t WS_H = 140 * MiB;
constexpr size_t WS_Y = 204 * MiB;
constexpr size_t WS_R = 268 * MiB;
constexpr size_t WS_QKV = WS_R, WS_UE = WS_R + 96 * MiB, WS_MIX = WS_R + 128 * MiB;
constexpr size_t WS_UO = WS_R, WS_POOL = WS_R + 64 * MiB;
constexpr size_t WS_HR = WS_R, WS_HS = WS_R + 129 * MiB, WS_SOUT = WS_R + 145 * MiB, WS_PAIR = WS_R + 209 * MiB;
constexpr size_t WS_X = WS_PAIR + 256 * MiB;
constexpr size_t WS_H8 = WS_X + 64 * MiB;
constexpr size_t WS_DUMP = WS_H8 + 32 * MiB;
constexpr size_t WS_END = WS_DUMP + 1 * MiB;
constexpr int CW_BAR = 4096;
constexpr int CW_CNT = 8192;

constexpr int SCR_BYTES = 139264;
constexpr int TAB_OFF = SCR_BYTES;
constexpr int MISC_OFF = TAB_OFF + 1024;
constexpr int LDS_BYTES = 147456;

#define XB_TMO      128
#define XB_XCNT(j)  (256  + 64 * (j))
#define XB_XSUB(j)  (1280 + 64 * (j))
#define XB_XGEN(j)  (2304 + 64 * (j))
#define XB_TOP      3328
#define XB_TOPGEN   3392
#define XCD_BAR_WORDS 3456
#define XB_SPIN_CAP (1u << 18)
__device__ __forceinline__ unsigned xb_ld(unsigned* p)              { return __hip_atomic_load(p, __ATOMIC_RELAXED, __HIP_MEMORY_SCOPE_AGENT); }
__device__ __forceinline__ unsigned xb_add(unsigned* p, unsigned v) { return __hip_atomic_fetch_add(p, v, __ATOMIC_RELAXED, __HIP_MEMORY_SCOPE_AGENT); }
__device__ __forceinline__ unsigned xb_xcc_id() { return (unsigned)__builtin_amdgcn_s_getreg((3 << 11) | 20) & 0xFu; }
#define XB_SPIN(cond, bar) do { unsigned _sp = 0; while (cond) { __builtin_amdgcn_s_sleep(1); \
    if ((++_sp & 255u) == 0u) { if (xb_ld(&(bar)[XB_TMO])) break; if (_sp > XB_SPIN_CAP) { atomicAdd(&(bar)[XB_TMO], 1u); break; } } } } while (0)
struct XcdBarrier { unsigned* bar; unsigned x; volatile LAS unsigned* st; };
__device__ __forceinline__ XcdBarrier xcd_barrier_post(unsigned* bar, volatile LAS unsigned* st) {
    XcdBarrier b; b.bar = bar; b.x = xb_xcc_id(); b.st = st;
    if (threadIdx.x == 0) (void)xb_add(&bar[XB_XCNT(b.x)], 1u);
    return b;
}
__device__ __forceinline__ void xcd_barrier_complete(unsigned* bar, unsigned x, unsigned& nloc, unsigned& nx) {
    const unsigned G = gridDim.x * gridDim.y * gridDim.z;
    unsigned sum, cnt, mine, sp = 0u;
    for (;;) {
        sum = 0u; cnt = 0u; mine = 0u;
#pragma unroll
        for (unsigned j = 0; j < 16; ++j) { const unsigned c = xb_ld(&bar[XB_XCNT(j)]); sum += c; cnt += (c > 0u) ? 1u : 0u; mine = (j == x) ? c : mine; }
        if (sum == G) break;
        __builtin_amdgcn_s_sleep(1);
        if ((++sp & 255u) == 0u) { if (xb_ld(&bar[XB_TMO])) break; if (sp > XB_SPIN_CAP) { atomicAdd(&bar[XB_TMO], 1u); break; } }
    }
    nloc = mine > 0u ? mine : 1u; nx = cnt > 0u ? cnt : 1u;
}
__device__ __forceinline__ void xcd_barrier(const XcdBarrier& b) {
    asm volatile("s_waitcnt vmcnt(0)" ::: "memory");
    __syncthreads();
    if (threadIdx.x == 0) {
        unsigned* bar = b.bar;
        __builtin_amdgcn_s_waitcnt(0);
        unsigned nloc = b.st[0], nx = b.st[1];
        if (nloc == 0u) { xcd_barrier_complete(bar, b.x, nloc, nx); b.st[0] = nloc; b.st[1] = nx; }
        const unsigned mygen = b.st[2]; b.st[2] = mygen + 1u;
        const unsigned old = xb_add(&bar[XB_XSUB(b.x)], 1u);
        const unsigned gen = old / nloc;
        asm volatile("buffer_inv sc1" ::: "memory");
        if (old + 1u == (gen + 1u) * nloc) {
            __builtin_amdgcn_fence(__ATOMIC_RELEASE, "agent");
            asm volatile("s_waitcnt vmcnt(0)" ::: "memory");
            (void)xb_add(&bar[XB_TOP], 1u);
        }
        XB_SPIN(xb_ld(&bar[XB_TOP]) < (mygen + 1u) * nx, bar);
        asm volatile("s_waitcnt vmcnt(0)" ::: "memory");
    }
    __syncthreads();
}

struct Ctx {
    LAS unsigned char* lds; LAS int* tab;
    int tid, lane, wave, vcu, G;
    const float* xin; const float* w1; const float* w3; const float* w2;
    float* X;
    unsigned char* ws;
};
constexpr int V_N1G = 0, V_N2G = 4096, V_DWW = 8192, V_DWB = V_DWW + 2 * 31 * 512, V_LNG = V_DWB + 1024, V_LNB = V_LNG + 1024, V_BIAS = V_LNB + 1024, V_FING = V_BIAS + 256, V_END = V_FING + 1024;
#define VEC(off) ((const float*)(C.ws + WS_VEC) + (off))
#define WSB(off) ((bf16*)(C.ws + (off)))
__device__ __forceinline__ Ctx phase_ctx(const Ctx& C0) { Ctx C = C0;
    { int t_ = (int)threadIdx.x; asm volatile("" : "+v"(t_)); C.tid = t_; C.lane = t_ & 63; }
    { GAS unsigned char* g_ = (GAS unsigned char*)C.ws; asm volatile("" : "+s"(g_)); C.ws = (unsigned char*)g_; }
    { GAS float* g_ = (GAS float*)C.X; asm volatile("" : "+s"(g_)); C.X = (float*)g_; }
    { const GAS float* g_ = (const GAS float*)C.xin; asm volatile("" : "+s"(g_)); C.xin = (const float*)g_; }
    asm volatile("" : "+s"(C.wave), "+s"(C.vcu)); return C; }

__device__ __forceinline__ void tr_item(const float* W, int N, int K, int k0, int n0, bf16* WT, int drow, LAS float* scr, int lane) {
#pragma unroll 8
    for (int i = 0; i < 32; ++i) { const int kk = 2 * i + (lane >> 5); scr[kk * 33 + (lane & 31)] = W[(size_t)(k0 + kk) * N + n0 + (lane & 31)]; }
    LDS_WAIT(); asm volatile("" ::: "memory");
    const int c = lane & 7;
#pragma unroll
    for (int j = 0; j < 4; ++j) { const int n = (lane >> 3) + 8 * j; const LAS float* s = scr + (8 * c) * 33 + n;
        u32x4 o; o.x = pk2(s[0 * 33], s[1 * 33]); o.y = pk2(s[2 * 33], s[3 * 33]); o.z = pk2(s[4 * 33], s[5 * 33]); o.w = pk2(s[6 * 33], s[7 * 33]);
        *(GAS u32x4*)(WT + (size_t)(drow + n) * K + k0 + 8 * c) = o; }
    LDS_WAIT(); asm volatile("" ::: "memory");
}
__device__ __forceinline__ void tr_item8(const float* W, int N, int K, int k0, int n0, unsigned char* WT8, int drow, LAS float* scr, int lane, int shift) {
#pragma unroll 8
    for (int i = 0; i < 32; ++i) { const int kk = 2 * i + (lane >> 5); scr[kk * 33 + (lane & 31)] = W[(size_t)(k0 + kk) * N + n0 + (lane & 31)]; }
    LDS_WAIT(); asm volatile("" ::: "memory");
    const int c = lane & 3; const float sc = (float)(1 << shift);
#pragma unroll
    for (int j = 0; j < 2; ++j) { const int n = (lane >> 2) + 16 * j; const LAS float* s = scr + (16 * c) * 33 + n; u32x4 o;
#pragma unroll
        for (int q = 0; q < 4; ++q) { int t_ = __builtin_amdgcn_cvt_pk_fp8_f32(s[(4 * q) * 33] * sc, s[(4 * q + 1) * 33] * sc, 0, false); o[q] = (unsigned)__builtin_amdgcn_cvt_pk_fp8_f32(s[(4 * q + 2) * 33] * sc, s[(4 * q + 3) * 33] * sc, t_, true); }
        *(GAS u32x4*)(WT8 + (size_t)(drow + n) * K + k0 + 16 * c) = o; }
    LDS_WAIT(); asm volatile("" ::: "memory");
}
struct CvItem { const float* W; unsigned char* D; int N, K, k0, n0, drow, shift; };
__device__ __forceinline__ CvItem cv_decode(const Ctx& C, int l, int it) {
    CvItem v; const int e = it / 384, r = it % 384, which = r >> 7, q = r & 127;
    if (which < 2) { const int kb = q >> 1, nb = q & 1; v.W = (which == 0 ? C.w1 : C.w3) + (size_t)(l * 64 + e) * 1024 * 256; v.N = 256; v.K = 1024; v.k0 = 16 * kb; v.n0 = 128 * nb;
        v.D = C.ws + WS_W13 + (size_t)(l & 1) * (32 * MiB) + (size_t)e * 512 * 1024; v.drow = nb * 256 + (which ? 128 : 0); v.shift = pg8::FP8_SHIFT_G1; }
    else { const int kb = q >> 3, nb = q & 7; v.W = C.w2 + (size_t)(l * 64 + e) * 256 * 1024; v.N = 1024; v.K = 256; v.k0 = 16 * kb; v.n0 = 128 * nb;
        v.D = C.ws + WS_W2 + (size_t)(l & 1) * (16 * MiB) + (size_t)e * 1024 * 256; v.drow = 128 * nb; v.shift = pg8::FP8_SHIFT_G2; }
    return v;
}
__device__ __forceinline__ void cv_load(const CvItem& v, f32x4 (&x)[8], int lane) {
#pragma unroll
    for (int i = 0; i < 8; ++i) x[i] = *(const f32x4*)(v.W + (size_t)(v.k0 + 2 * i + (lane >> 5)) * v.N + v.n0 + 4 * (lane & 31));
}
__device__ __forceinline__ void cv_finish(const CvItem& v, const f32x4 (&x)[8], LAS float* scr, int lane) {
#pragma unroll
    for (int i = 0; i < 8; ++i) *(LAS f32x4*)(scr + (2 * i + (lane >> 5)) * 132 + 4 * (lane & 31)) = x[i];
    LDS_WAIT(); asm volatile("" ::: "memory");
    const float sc = (float)(1 << v.shift);
#pragma unroll
    for (int j = 0; j < 2; ++j) { const int n = lane + 64 * j; const LAS float* s = scr + n; u32x4 o;
#pragma unroll
        for (int q = 0; q < 4; ++q) { int t_ = __builtin_amdgcn_cvt_pk_fp8_f32(s[(4 * q) * 132] * sc, s[(4 * q + 1) * 132] * sc, 0, false); o[q] = (unsigned)__builtin_amdgcn_cvt_pk_fp8_f32(s[(4 * q + 2) * 132] * sc, s[(4 * q + 3) * 132] * sc, t_, true); }
        *(GAS u32x4*)(v.D + (size_t)(v.drow + n) * v.K + v.k0) = o; }
    LDS_WAIT(); asm volatile("" ::: "memory");
}
__device__ __forceinline__ void moe_convert(const Ctx& C, int l, LAS float* scr, int gw, int NGW, int first = 0, int count = 64 * 384) {
    const int end = first + count;
    for (int it = first + gw; it < end; it += 4 * NGW) {
        const CvItem v0 = cv_decode(C, l, it), v1 = cv_decode(C, l, it + NGW < end ? it + NGW : end - 1), v2 = cv_decode(C, l, it + 2 * NGW < end ? it + 2 * NGW : end - 1), v3 = cv_decode(C, l, it + 3 * NGW < end ? it + 3 * NGW : end - 1);
        f32x4 x0[8], x1[8], x2[8], x3[8];
        cv_load(v0, x0, C.lane); cv_load(v1, x1, C.lane); cv_load(v2, x2, C.lane); cv_load(v3, x3, C.lane);
        cv_finish(v0, x0, scr, C.lane);
        if (it + NGW < end) cv_finish(v1, x1, scr, C.lane);
        if (it + 2 * NGW < end) cv_finish(v2, x2, scr, C.lane);
        if (it + 3 * NGW < end) cv_finish(v3, x3, scr, C.lane);
    }
}
template <class ArgsT>
__device__ __forceinline__ void prologue(const Ctx& C, const ArgsT& A) {
    LAS float* condT = (LAS float*)C.lds;
    LAS float* scr = (LAS float*)(C.lds + 32768 + C.wave * 8448);
    { float cv[16];
#pragma unroll
      for (int q = 0; q < 16; ++q) cv[q] = A.in[1][C.tid + NWAVES * 64 * q];
#pragma unroll
      for (int q = 0; q < 16; ++q) { const int idx = C.tid + NWAVES * 64 * q, b = idx >> 10, k = idx & 1023; condT[k * 8 + b] = cv[q] * sigmoidf_(cv[q]); } }
    __syncthreads();
    const int gw = C.vcu * NWAVES + C.wave, NGW = C.G * NWAVES;
    float* MOD = (float*)(C.ws + WS_MOD);
    for (int it = gw; it < 4 * 384; it += NGW) {
        const int l = it / 384, c0 = (it % 384) * 16, cc = C.lane & 15, kq = C.lane >> 4;
        const float* wp = A.in[2] + ((size_t)l * 1024 + kq * 256) * 6144 + c0 + cc;
        float acc[8];
#pragma unroll
        for (int b = 0; b < 8; ++b) acc[b] = 0.f;
#pragma unroll 8
        for (int kk = 0; kk < 256; ++kk) { const float w = wp[(size_t)kk * 6144]; const LAS f32x4* cv = (const LAS f32x4*)(condT + (kq * 256 + kk) * 8); const f32x4 c0v = cv[0], c1v = cv[1];
            acc[0] += w * c0v[0]; acc[1] += w * c0v[1]; acc[2] += w * c0v[2]; acc[3] += w * c0v[3]; acc[4] += w * c1v[0]; acc[5] += w * c1v[1]; acc[6] += w * c1v[2]; acc[7] += w * c1v[3]; }
#pragma unroll
        for (int b = 0; b < 8; ++b) { acc[b] += __shfl_xor(acc[b], 16); acc[b] += __shfl_xor(acc[b], 32); }
        if (C.lane < 16) { const float bb = A.in[3][l * 6144 + c0 + cc];
#pragma unroll
            for (int b = 0; b < 8; ++b) MOD[(size_t)(l * 8 + b) * 6144 + c0 + cc] = acc[b] + bb; }
    }
    { LAS float* wt = (LAS float*)(C.lds + 102400);
      for (int bi = C.vcu; bi < 256; bi += C.G) {
        const int nq = bi & 3, kt = (bi >> 2) & 7, g = (bi >> 5) & 3, i = bi >> 7, r = C.lane & 31, h = C.lane >> 5, nt_ = nq * 8 + C.wave;
        __syncthreads();
        { const float* wgb = A.in[13] + ((size_t)(i * 4 + g) * 256 + kt * 32) * 256; const float* scb = A.in[14] + i * 1024 + g * 256;
#pragma unroll
          for (int q = 0; q < 4; ++q) { const int idx = C.tid + 512 * q, row = idx >> 6, c4 = idx & 63; const f32x4 v = *(const f32x4*)(wgb + row * 256 + 4 * c4), sc4 = *(const f32x4*)(scb + 4 * c4);
              LAS float* d = wt + row * 257 + 4 * c4; d[0] = v[0] * sc4[0]; d[1] = v[1] * sc4[1]; d[2] = v[2] * sc4[2]; d[3] = v[3] * sc4[3]; } }
        __syncthreads();
        const float* wo = A.in[15] + ((size_t)i * 1024 + g * 256 + h) * 1024 + nt_ * 32 + r; const LAS float* wb = wt + r * 257 + h;
        f32x16 acc;
#pragma unroll
        for (int q = 0; q < 16; ++q) acc[q] = 0.f;
#pragma unroll 16
        for (int s_ = 0; s_ < 128; ++s_) acc = __builtin_amdgcn_mfma_f32_32x32x2f32(wo[(size_t)(2 * s_) * 1024], wb[2 * s_], acc, 0, 0, 0);
        unsigned char* wc = C.ws + WS_WC + ((size_t)i * 1024 + nt_ * 32 + 4 * h) * 1024 + g * 256 + kt * 32 + r;
#pragma unroll
        for (int q = 0; q < 16; ++q) wc[(size_t)((q & 3) + 8 * (q >> 2)) * 1024] = (unsigned char)(__builtin_amdgcn_cvt_pk_fp8_f32(acc[q] * (float)(1 << pg8::FP8_SHIFT_G1), 0.f, 0, false) & 0xff);
      }
      __syncthreads(); }
    constexpr int S0 = 2560, S1 = S0 + 1024, S2 = S1 + 1024, S3 = S2 + 128, S4 = S3 + 512, S5 = S4 + 512, S6 = S5 + 512;
    for (int it = gw; it < S6; it += NGW) {
        if (it < S0) { const int i = it / 1280, q = it % 1280, kb = q / 80, nb = q % 80, n0 = 32 * nb; int drow;
            if (n0 < 1536) drow = n0; else { int j = n0 - 1536; const int gate = j >= 512; if (gate) j -= 512; drow = 1536 + (j >> 7) * 256 + ((j & 127) >> 5) * 64 + (gate ? 32 : 0) + (j & 31); }
            tr_item8(A.in[6] + (size_t)i * 1024 * 2560, 2560, 1024, 64 * kb, n0, C.ws + WS_WINE + (size_t)i * 2560 * 1024, drow, scr, C.lane, pg8::FP8_SHIFT_G1); }
        else if (it < S1) { const int q = it - S0, i = q >> 9, r = q & 511; tr_item8(A.in[11] + (size_t)i * 1024 * 1024, 1024, 1024, 64 * (r >> 5), 32 * (r & 31), C.ws + WS_WOUTE + (size_t)i * 1024 * 1024, 32 * (r & 31), scr, C.lane, pg8::FP8_SHIFT_G1); }
        else if (it < S2) { const int q = it - S1, i = q >> 9, r = q & 511; tr_item8(A.in[12] + (size_t)i * 1024 * 1024, 1024, 1024, 64 * (r >> 5), 32 * (r & 31), C.ws + WS_WINO + (size_t)i * 1024 * 1024, 32 * (r & 31), scr, C.lane, pg8::FP8_SHIFT_G1); }
        else if (it < S3) { const int q = it - S2, l = q >> 5, r = q & 31; tr_item(A.in[16] + (size_t)l * 1024 * 64, 64, 1024, 64 * (r >> 1), 32 * (r & 1), WSB(WS_WR) + (size_t)l * 64 * 1024, 32 * (r & 1), scr, C.lane); }
        else if (it < S5) { const int which = it >= S4, q = it - (which ? S4 : S3), l = q >> 7, r = q & 127, n0 = 32 * (r & 7);
            tr_item8(A.in[which ? 22 : 21] + (size_t)l * 1024 * 256, 256, 1024, 64 * (r >> 3), n0, C.ws + WS_WS13 + (size_t)l * 512 * 1024, (n0 >> 7) * 256 + (n0 & 127) + (which ? 128 : 0), scr, C.lane, pg8::FP8_SHIFT_G1); }
        else { const int q = it - S5, l = q >> 7, r = q & 127; tr_item8(A.in[23] + (size_t)l * 256 * 1024, 1024, 256, 64 * (r >> 5), 32 * (r & 31), C.ws + WS_WS2 + (size_t)l * 1024 * 256, 32 * (r & 31), scr, C.lane, pg8::FP8_SHIFT_G2); }
    }
    { float* V = (float*)(C.ws + WS_VEC); const int gt = C.vcu * NWAVES * 64 + C.tid, NT = C.G * NWAVES * 64;
      for (int i = gt; i < V_END; i += NT) { float v;
          if (i < V_N2G) v = A.in[4][i]; else if (i < V_DWW) v = A.in[5][i - V_N2G]; else if (i < V_DWB) v = A.in[7][i - V_DWW]; else if (i < V_LNG) v = A.in[8][i - V_DWB];
          else if (i < V_LNB) v = A.in[9][i - V_LNG]; else if (i < V_BIAS) v = A.in[10][i - V_LNB]; else if (i < V_FING) v = A.in[17][i - V_BIAS]; else v = A.in[24][i - V_FING];
          V[i] = v; } }
    moe_convert(C, 0, scr, gw, NGW);
}

__device__ __forceinline__ void build_tables(const Ctx& C, int l) {
    __syncthreads();
    if (C.wave == 0) {
        const int n = (int)__hip_atomic_load((unsigned*)(C.ws + WS_CTL) + CW_CNT + (l * 64 + C.lane) * 16, RLX_AGENT);
        int tl = (n + 255) >> 8, cn = n;
#pragma unroll
        for (int o = 1; o < 64; o <<= 1) { const int a = __shfl_up(tl, o), b = __shfl_up(cn, o); if (C.lane >= o) { tl += a; cn += b; } }
        C.tab[1 + C.lane] = tl; C.tab[81 + C.lane] = cn; C.tab[160 + C.lane] = n;
        { LAS unsigned short* tmap = (LAS unsigned short*)(C.tab + 512); const int nt_ = (n + 255) >> 8; for (int j = tl - nt_; j < tl; ++j) tmap[j] = (unsigned short)C.lane; }
        if (C.lane == 0) { C.tab[0] = 0; C.tab[80] = 0; }
    }
    __syncthreads();
}

__device__ __forceinline__ void unpack16(const u32x4& a, const u32x4& b, f32x4 (&v)[4]) {
    v[0] = (f32x4){bflo(a.x), bfhi(a.x), bflo(a.y), bfhi(a.y)}; v[1] = (f32x4){bflo(a.z), bfhi(a.z), bflo(a.w), bfhi(a.w)};
    v[2] = (f32x4){bflo(b.x), bfhi(b.x), bflo(b.y), bfhi(b.y)}; v[3] = (f32x4){bflo(b.z), bfhi(b.z), bflo(b.w), bfhi(b.w)}; }
__device__ __forceinline__ void pack16(const f32x4 (&v)[4], u32x4& a, u32x4& b) {
    a.x = pk2(v[0][0], v[0][1]); a.y = pk2(v[0][2], v[0][3]); a.z = pk2(v[1][0], v[1][1]); a.w = pk2(v[1][2], v[1][3]);
    b.x = pk2(v[2][0], v[2][1]); b.y = pk2(v[2][2], v[2][3]); b.z = pk2(v[3][0], v[3][1]); b.w = pk2(v[3][2], v[3][3]); }
__device__ __forceinline__ f32x4 fp8x4(unsigned w) { const f32x2 lo = __builtin_amdgcn_cvt_pk_f32_fp8((int)w, false), hi = __builtin_amdgcn_cvt_pk_f32_fp8((int)w, true); return (f32x4){lo.x, lo.y, hi.x, hi.y}; }
template <int MODE, bool DRY = false>
__device__ __forceinline__ void row_phase(const Ctx& C, int l) {
    const float* MOD = (const float*)(C.ws + WS_MOD);
    bf16* H = WSB(WS_H); bf16* X = WSB(WS_X);
    bf16* Xd = DRY ? WSB(WS_R) : X; bf16* Hd = DRY ? WSB(WS_R + 64 * MiB) : H; float* PWd = DRY ? (float*)(C.ws + WS_R + 128 * MiB) : (float*)(C.ws + WS_PW);
    const int lane = C.lane, e0 = 16 * lane;
    LAS unsigned char* tileA = C.lds;
    LAS float* part = (LAS float*)(C.lds + 66048);
    if (MODE == 1 || MODE == 3) build_tables(C, l - 1);
    unsigned selbits = 0u;
    const int ntile = NTOK / 32;
    bf16x8 wrf[2][8];
    if (MODE == 2) { const int r_ = lane & 31, hi_ = lane >> 5; const bf16* wr = WSB(WS_WR) + (size_t)l * 64 * 1024;
#pragma unroll
        for (int s_ = 0; s_ < 8; ++s_) { const int kc = 128 * C.wave + 16 * s_ + 8 * hi_; wrf[0][s_] = *(const bf16x8*)(wr + (size_t)r_ * 1024 + kc); wrf[1][s_] = *(const bf16x8*)(wr + (size_t)(32 + r_) * 1024 + kc); } }
    u32x4 rx[4][2];
    if (MODE == 2) { const int tile = C.vcu; if (tile < ntile) { const size_t tb = (size_t)(tile * 32 + C.wave * 4) * DM + e0;
#pragma unroll
        for (int t = 0; t < 4; ++t) { rx[t][0] = *(const u32x4*)(X + tb + t * DM); rx[t][1] = *(const u32x4*)(X + tb + t * DM + 8); } } }
    for (int it = 0; ; ++it) {
        const int tile = C.vcu + it * C.G; if (tile >= ntile) break;
        const int b = tile >> 7, tokb = tile * 32 + C.wave * 4;
        f32x4 ga[4], av[4], sh[4];
#pragma unroll
        for (int q = 0; q < 4; ++q) { const int c = e0 + 4 * q;
            if (MODE == 0 || MODE == 1) { const float* m = MOD + (size_t)(l * 8 + b) * 6144; const f32x4 g = *(const f32x4*)(VEC(V_N1G) + l * 1024 + c);
                sh[q] = *(const f32x4*)(m + c); av[q] = g * (*(const f32x4*)(m + 1024 + c) + 1.f);
                if (MODE == 1) ga[q] = *(const f32x4*)(MOD + (size_t)((l - 1) * 8 + b) * 6144 + 5 * 1024 + c); else ga[q] = (f32x4){0.f, 0.f, 0.f, 0.f}; }
            else if (MODE == 2) { const float* m = MOD + (size_t)(l * 8 + b) * 6144; const f32x4 g = *(const f32x4*)(VEC(V_N2G) + l * 1024 + c);
                ga[q] = *(const f32x4*)(m + 2 * 1024 + c); sh[q] = *(const f32x4*)(m + 3 * 1024 + c); av[q] = g * (*(const f32x4*)(m + 4 * 1024 + c) + 1.f); }
            else { ga[q] = *(const f32x4*)(MOD + (size_t)(3 * 8 + b) * 6144 + 5 * 1024 + c); av[q] = *(const f32x4*)(VEC(V_FING) + c); sh[q] = (f32x4){0.f, 0.f, 0.f, 0.f}; }
        }
#define ROW_FINISH(NB, T0) do { float ss[NB]; \
            _Pragma("unroll") for (int t = 0; t < NB; ++t) { float a_ = 0.f; _Pragma("unroll") for (int q = 0; q < 4; ++q) a_ += (x[t][q][0] * x[t][q][0] + x[t][q][1] * x[t][q][1]) + (x[t][q][2] * x[t][q][2] + x[t][q][3] * x[t][q][3]); ss[t] = a_; } \
            _Pragma("unroll") for (int t = 0; t < NB; ++t) ss[t] = wave_sum(ss[t]); \
            _Pragma("unroll") for (int t = 0; t < NB; ++t) { const int tok = tokb + (T0) + t; const float rs = __builtin_amdgcn_rsqf(ss[t] * (1.f / DM) + EPS); \
                if (MODE == 3) { _Pragma("unroll") for (int q = 0; q < 4; ++q) *(f32x4*)(C.X + (size_t)tok * DM + e0 + 4 * q) = x[t][q] * rs * av[q]; } \
                else { if (MODE != 2) { u32x4 xa, xb; pack16(x[t], xa, xb); *(u32x4*)(Xd + (size_t)tok * DM + e0) = xa; *(u32x4*)(Xd + (size_t)tok * DM + e0 + 8) = xb; } \
                    f32x4 hv[4]; _Pragma("unroll") for (int q = 0; q < 4; ++q) hv[q] = x[t][q] * rs * av[q] + sh[q]; \
                    u32x4 ha, hb; pack16(hv, ha, hb); if (MODE != 2) { u32x4 h8_; _Pragma("unroll") for (int q = 0; q < 4; ++q) { int t_ = __builtin_amdgcn_cvt_pk_fp8_f32(hv[q][0], hv[q][1], 0, false); h8_[q] = (unsigned)__builtin_amdgcn_cvt_pk_fp8_f32(hv[q][2], hv[q][3], t_, true); } \
                        *(u32x4*)((unsigned char*)Hd + (size_t)tok * DM + e0) = h8_; } \
                    if (MODE == 2) { LAS unsigned char* tp = tileA + (C.wave * 4 + (T0) + t) * 2064 + e0 * 2; *(LAS u32x4*)tp = ha; *(LAS u32x4*)(tp + 16) = hb; \
                        if (!DRY) { u32x4 h8; _Pragma("unroll") for (int q = 0; q < 4; ++q) { int t_ = __builtin_amdgcn_cvt_pk_fp8_f32(hv[q][0], hv[q][1], 0, false); h8[q] = (unsigned)__builtin_amdgcn_cvt_pk_fp8_f32(hv[q][2], hv[q][3], t_, true); } \
                            *(u32x4*)(C.ws + WS_H8 + (size_t)tok * DM + e0) = h8; } } } } } while (0)
        if (MODE == 0) {
            f32x4 x[4][4];
#pragma unroll
            for (int t = 0; t < 4; ++t)
#pragma unroll
                for (int q = 0; q < 4; ++q) x[t][q] = *(const f32x4*)(C.xin + (size_t)(tokb + t) * DM + e0 + 4 * q);
            ROW_FINISH(4, 0);
        } else if (MODE == 2) {
#pragma unroll
            for (int hb2 = 0; hb2 < 2; ++hb2) { f32x4 x[2][4];
#pragma unroll
                for (int t = 0; t < 2; ++t) unpack16(rx[2 * hb2 + t][0], rx[2 * hb2 + t][1], x[t]);
                ROW_FINISH(2, 2 * hb2); }
            { const int tn = tile + C.G; if (tn < ntile) { const size_t tb = (size_t)(tn * 32 + C.wave * 4) * DM + e0;
#pragma unroll
                for (int t = 0; t < 4; ++t) { rx[t][0] = *(const u32x4*)(X + tb + t * DM); rx[t][1] = *(const u32x4*)(X + tb + t * DM + 8); } } }
        } else {
            const int* pep = (const int*)(C.ws + WS_PEP) + (size_t)tokb * 8; const float* pw = (const float*)(C.ws + WS_PW) + (size_t)tokb * 8;
            const int epv = pep[lane & 31]; const float pwv = pw[lane & 31];
#pragma unroll
            for (int hb2 = 0; hb2 < 2; ++hb2) {
                u32x4 qx[2][2], qs[2][2], qp[2][8];
#pragma unroll
                for (int t = 0; t < 2; ++t) { const size_t tb = (size_t)(tokb + 2 * hb2 + t) * DM + e0;
                    qx[t][0] = *(const u32x4*)(X + tb); qx[t][1] = *(const u32x4*)(X + tb + 8); qs[t][0] = *(const u32x4*)(WSB(WS_SOUT) + tb); qs[t][1] = *(const u32x4*)(WSB(WS_SOUT) + tb + 8);
#pragma unroll
                    for (int k = 0; k < 8; ++k) { const int ep = __builtin_amdgcn_readlane(epv, 8 * (2 * hb2 + t) + k); const int row = C.tab[80 + (ep >> 16)] + (ep & 0xffff);
                        qp[t][k] = *(const u32x4*)(C.ws + WS_PAIR + (size_t)row * DM + e0); } }
                f32x4 x[2][4];
#pragma unroll
                for (int t = 0; t < 2; ++t) { f32x4 v[4]; unpack16(qx[t][0], qx[t][1], x[t]); unpack16(qs[t][0], qs[t][1], v);
#pragma unroll
                    for (int k = 0; k < 8; ++k) { const float w = __builtin_bit_cast(float, __builtin_amdgcn_readlane(__builtin_bit_cast(int, pwv), 8 * (2 * hb2 + t) + k));
                        v[0] += w * fp8x4(qp[t][k].x); v[1] += w * fp8x4(qp[t][k].y); v[2] += w * fp8x4(qp[t][k].z); v[3] += w * fp8x4(qp[t][k].w); }
#pragma unroll
                    for (int q = 0; q < 4; ++q) x[t][q] += ga[q] * v[q]; }
                ROW_FINISH(2, 2 * hb2);
            }
        }
#undef ROW_FINISH
        if (MODE == 2) {
#define LDS_BARRIER() do { LDS_WAIT(); __builtin_amdgcn_s_barrier(); } while (0)
            LDS_BARRIER();
            { const int r = lane & 31, hi = lane >> 5;
              f32x16 a0, a1;
#pragma unroll
              for (int i = 0; i < 16; ++i) { a0[i] = 0.f; a1[i] = 0.f; }
#pragma unroll
              for (int s = 0; s < 8; ++s) { const int kc = 128 * C.wave + 16 * s + 8 * hi;
                  const bf16x8 af = *(const LAS bf16x8*)(tileA + r * 2064 + kc * 2);
                  a0 = __builtin_amdgcn_mfma_f32_32x32x16_bf16(af, wrf[0][s], a0, 0, 0, 0); a1 = __builtin_amdgcn_mfma_f32_32x32x16_bf16(af, wrf[1][s], a1, 0, 0, 0); }
#pragma unroll
              for (int i = 0; i < 16; ++i) { const int trow = (i & 3) + 8 * (i >> 2) + 4 * hi; part[(C.wave * 32 + trow) * 64 + r] = a0[i]; part[(C.wave * 32 + trow) * 64 + 32 + r] = a1[i]; } }
            LDS_BARRIER();
            const float bias = VEC(V_BIAS)[l * 64 + lane];
#pragma unroll
            for (int ti = 0; ti < 4; ++ti) {
                const int trow = C.wave * 4 + ti, tok = tile * 32 + trow;
                float logit = 0.f;
#pragma unroll
                for (int w = 0; w < 8; ++w) logit += part[(w * 32 + trow) * 64 + lane];
                const float sc = sigmoidf_(logit), bi = sc + bias;
#define DPPF(v, ctrl) __builtin_bit_cast(float, __builtin_amdgcn_update_dpp(0, __builtin_bit_cast(int, (v)), (ctrl), 0xf, 0xf, false))
                float m1 = bi; m1 = fmaxf(m1, DPPF(m1, 0xB1)); m1 = fmaxf(m1, DPPF(m1, 0x4E)); m1 = fmaxf(m1, DPPF(m1, 0x141));
                const unsigned long long eq = __ballot(bi == m1); const int grp = lane >> 3; const unsigned gm = (unsigned)(eq >> (grp * 8)) & 0xffu;
                const bool isfirst = (lane & 7) == (__ffs((int)gm) - 1);
                float m2 = isfirst ? -INFINITY : bi; m2 = fmaxf(m2, DPPF(m2, 0xB1)); m2 = fmaxf(m2, DPPF(m2, 0x4E)); m2 = fmaxf(m2, DPPF(m2, 0x141));
                const float gs = m1 + m2; int grank = 0;
#pragma unroll
                for (int g2 = 0; g2 < 8; ++g2) { const float o = __builtin_bit_cast(float, __builtin_amdgcn_readlane(__builtin_bit_cast(int, gs), 8 * g2)); grank += (o > gs || (o == gs && g2 < grp)) ? 1 : 0; }
                const bool gsel = grank < 4;
                const float key = gsel ? __builtin_bit_cast(float, (__builtin_bit_cast(unsigned, bi) & 0xFFFFFFC0u) | (unsigned)(63 - lane)) : -INFINITY; int rk = 0;
                const unsigned long long gb = __ballot(gsel);
#pragma unroll
                for (int g2 = 0; g2 < 8; ++g2) { if ((gb >> (8 * g2)) & 1ull) {
#pragma unroll
                    for (int e3 = 0; e3 < 8; ++e3) { const float o = __builtin_bit_cast(float, __builtin_amdgcn_readlane(__builtin_bit_cast(int, key), 8 * g2 + e3)); rk += (o > key) ? 1 : 0; } } }
                const bool sel = gsel && rk < 8;
                float ssum = sel ? sc : 0.f; ssum += DPPF(ssum, 0xB1); ssum += DPPF(ssum, 0x4E); ssum += DPPF(ssum, 0x141); ssum += DPPF(ssum, 0x140);
                ssum = __builtin_bit_cast(float, __builtin_amdgcn_readlane(__builtin_bit_cast(int, ssum), 0)) + __builtin_bit_cast(float, __builtin_amdgcn_readlane(__builtin_bit_cast(int, ssum), 16))
                     + __builtin_bit_cast(float, __builtin_amdgcn_readlane(__builtin_bit_cast(int, ssum), 32)) + __builtin_bit_cast(float, __builtin_amdgcn_readlane(__builtin_bit_cast(int, ssum), 48));
#undef DPPF
                const unsigned long long sm = __ballot(sel); const int kidx = __popcll(sm & ((1ull << lane) - 1ull));
                if (sel) PWd[(size_t)tok * 8 + kidx] = sc / ssum * 2.5f;
                selbits |= (sel ? 1u : 0u) << (it * 4 + ti);
            }
            LDS_BARRIER();
#undef LDS_BARRIER
        }
    }
    if (MODE == 2 && !DRY) {
        const unsigned cnt = (unsigned)__popc(selbits);
        LAS unsigned* wcn = (LAS unsigned*)C.lds;
        wcn[C.wave * 64 + lane] = cnt; __syncthreads();
        if (C.wave == 0) { unsigned tot = 0u;
#pragma unroll
            for (int w = 0; w < 8; ++w) { const unsigned v = wcn[w * 64 + lane]; wcn[w * 64 + lane] = tot; tot += v; }
            unsigned bb = 0u; if (tot) bb = __hip_atomic_fetch_add((unsigned*)(C.ws + WS_CTL) + CW_CNT + (l * 64 + lane) * 16, tot, RLX_AGENT);
            wcn[512 + lane] = bb; }
        __syncthreads();
        const unsigned base = wcn[512 + lane] + wcn[C.wave * 64 + lane];
        int* tokof = (int*)(C.ws + WS_TOKOF) + (size_t)lane * 32768; int* pep = (int*)(C.ws + WS_PEP);
        for (int it = 0; ; ++it) { const int tile = C.vcu + it * C.G; if (tile >= ntile) break;
#pragma unroll 1
            for (int ti = 0; ti < 4; ++ti) { const int slot = it * 4 + ti, tok = tile * 32 + C.wave * 4 + ti; const bool sel = (selbits >> slot) & 1u;
                const unsigned long long sm = __ballot(sel); const int kidx = __popcll(sm & ((1ull << lane) - 1ull));
                if (sel) { const unsigned pos = base + (unsigned)__popc(selbits & ((1u << slot) - 1u)); tokof[pos] = tok; pep[(size_t)tok * 8 + kidx] = (int)(((unsigned)lane << 16) | pos); } } }
    }
}

template <bool FINAL, bool DRY = false>
__device__ __forceinline__ void combine_phase(const Ctx& C, int l) {
    const float* MOD = (const float*)(C.ws + WS_MOD);
    bf16* H = WSB(WS_H); bf16* X = WSB(WS_X);
    bf16* Hd = DRY ? WSB(WS_R) : H; bf16* Xd = DRY ? WSB(WS_Y) : X; float* Od = DRY ? (float*)(C.ws + WS_R) : C.X;
    const int lane = C.lane, e0 = 16 * lane, ntile = NTOK / 32;
#if MK_PER_PHASE
    build_tables(C, l - 1);
#endif
    if (C.vcu >= ntile) return;
    u32x4 pA[8], xA[2], sA[1], pB[8], xB[2], sB[1];
    int epv, epn = 0; float pwv, pwn = 0.f;
#define CMB_LOAD(P_, X_, S_, TOK, TI, EPV) do { const size_t tb = (size_t)(TOK) * DM + e0; \
        X_[0] = *(const u32x4*)(X + tb); X_[1] = *(const u32x4*)(X + tb + 8); S_[0] = *(const u32x4*)(C.ws + WS_SOUT + tb); \
        _Pragma("unroll") for (int k = 0; k < 8; ++k) { const int ep = __builtin_amdgcn_readlane((EPV), 8 * (TI) + k); const int row = C.tab[80 + (ep >> 16)] + (ep & 0xffff); \
            P_[k] = *(const u32x4*)(C.ws + WS_PAIR + (size_t)row * DM + e0); } } while (0)
#define CMB_COMPUTE(P_, X_, S_, TI) do { f32x4 x[4], v[4]; unpack16(X_[0], X_[1], x); v[0] = fp8x4(S_[0].x); v[1] = fp8x4(S_[0].y); v[2] = fp8x4(S_[0].z); v[3] = fp8x4(S_[0].w); \
        _Pragma("unroll") for (int k = 0; k < 8; ++k) { const float w = __builtin_bit_cast(float, __builtin_amdgcn_readlane(__builtin_bit_cast(int, pwv), 8 * (TI) + k)); \
            v[0] += w * fp8x4(P_[k].x); v[1] += w * fp8x4(P_[k].y); v[2] += w * fp8x4(P_[k].z); v[3] += w * fp8x4(P_[k].w); } \
        float ss = 0.f; _Pragma("unroll") for (int q = 0; q < 4; ++q) { x[q] += ga[q] * v[q]; ss += (x[q][0] * x[q][0] + x[q][1] * x[q][1]) + (x[q][2] * x[q][2] + x[q][3] * x[q][3]); } \
        const float rs = __builtin_amdgcn_rsqf(wave_sum(ss) * (1.f / DM) + EPS); \
        if (FINAL) { _Pragma("unroll") for (int q = 0; q < 4; ++q) ro[q] = x[q] * rs * av[q]; } \
        else { pack16(x, rxa, rxb); f32x4 hv[4]; _Pragma("unroll") for (int q = 0; q < 4; ++q) hv[q] = x[q] * rs * av[q] + sh[q]; \
            _Pragma("unroll") for (int q = 0; q < 4; ++q) { int t_ = __builtin_amdgcn_cvt_pk_fp8_f32(hv[q][0], hv[q][1], 0, false); rha[q] = (unsigned)__builtin_amdgcn_cvt_pk_fp8_f32(hv[q][2], hv[q][3], t_, true); } } } while (0)
#define CMB_STORE(TOK) do { const size_t tb = (size_t)(TOK) * DM + e0; \
        if (FINAL) { _Pragma("unroll") for (int q = 0; q < 4; ++q) *(f32x4*)(Od + tb + 4 * q) = ro[q]; } \
        else { *(u32x4*)(Xd + tb) = rxa; *(u32x4*)(Xd + tb + 8) = rxb; *(u32x4*)((unsigned char*)Hd + tb) = rha; } } while (0)
#define CMB_SB() __builtin_amdgcn_sched_barrier(0)
    { const int tokb0 = C.vcu * 32 + C.wave * 4; epv = ((const int*)(C.ws + WS_PEP))[(size_t)tokb0 * 8 + (lane & 31)]; pwv = ((const float*)(C.ws + WS_PW))[(size_t)tokb0 * 8 + (lane & 31)];
      CMB_LOAD(pA, xA, sA, tokb0, 0, epv); }
    for (int it = 0; ; ++it) {
        const int tile = C.vcu + it * C.G; if (tile >= ntile) break;
        const int tn = tile + C.G; const bool has_next = tn < ntile;
        const int b = tile >> 7, tokb = tile * 32 + C.wave * 4, tokn = tn * 32 + C.wave * 4;
        if (has_next) { epn = ((const int*)(C.ws + WS_PEP))[(size_t)tokn * 8 + (lane & 31)]; pwn = ((const float*)(C.ws + WS_PW))[(size_t)tokn * 8 + (lane & 31)]; }
        const float* mrow = MOD + (size_t)((FINAL ? 0 : l) * 8 + b) * 6144;
        f32x4 ga[4];
#pragma unroll
        for (int q = 0; q < 4; ++q) ga[q] = *(const f32x4*)(MOD + (size_t)((l - 1) * 8 + b) * 6144 + 5 * 1024 + e0 + 4 * q);
        f32x4 av[4], sh[4];
#pragma unroll
        for (int q = 0; q < 4; ++q) {
            if (FINAL) { av[q] = *(const f32x4*)(VEC(V_FING) + e0 + 4 * q); sh[q] = (f32x4){0.f, 0.f, 0.f, 0.f}; }
            else { const float* m_ = mrow + e0 + 4 * q; av[q] = *(const f32x4*)(VEC(V_N1G) + l * 1024 + e0 + 4 * q) * (*(const f32x4*)(m_ + 1024) + 1.f); sh[q] = *(const f32x4*)m_; } }
        f32x4 ro[4]; u32x4 rxa, rxb, rha, rhb;
        CMB_LOAD(pB, xB, sB, tokb + 1, 1, epv); CMB_SB(); CMB_COMPUTE(pA, xA, sA, 0); CMB_SB(); CMB_STORE(tokb + 0); CMB_SB();
        CMB_LOAD(pA, xA, sA, tokb + 2, 2, epv); CMB_SB(); CMB_COMPUTE(pB, xB, sB, 1); CMB_SB(); CMB_STORE(tokb + 1); CMB_SB();
        CMB_LOAD(pB, xB, sB, tokb + 3, 3, epv); CMB_SB(); CMB_COMPUTE(pA, xA, sA, 2); CMB_SB(); CMB_STORE(tokb + 2); CMB_SB();
        if (has_next) CMB_LOAD(pA, xA, sA, tokn, 0, epn);
        CMB_SB(); CMB_COMPUTE(pB, xB, sB, 3); CMB_SB(); CMB_STORE(tokb + 3); CMB_SB();
        epv = epn; pwv = pwn;
    }
#undef CMB_LOAD
#undef CMB_COMPUTE
#undef CMB_STORE
#undef CMB_SB
}

__device__ __forceinline__ void attn_wave_unit(const bf16* QKV, unsigned char* MIX, int b, int h, int qb, LAS unsigned char* vl, int lane) {
    const int r = lane & 31, hi = lane >> 5; const size_t tok0 = (size_t)b * SEQ; const int q0 = qb * 32;
    const bf16* qp = QKV + (tok0 + q0 + r) * 1536 + h * 64 + 8 * hi;
    bf16x8 qf[4];
#pragma unroll
    for (int kk = 0; kk < 4; ++kk) qf[kk] = *(const bf16x8*)(qp + 16 * kk);
    f32x16 o0, o1;
#pragma unroll
    for (int i = 0; i < 16; ++i) { o0[i] = 0.f; o1[i] = 0.f; }
    float P = 1.f;
    for (int kb = q0; kb >= 0; kb -= 32) {
        const bf16* kp = QKV + (tok0 + kb + r) * 1536 + 512 + h * 64 + 8 * hi;
        bf16x8 kf[4];
#pragma unroll
        for (int kk = 0; kk < 4; ++kk) kf[kk] = *(const bf16x8*)(kp + 16 * kk);
        const bf16* vp = QKV + (tok0 + kb + (lane >> 1)) * 1536 + 1024 + h * 64 + (lane & 1) * 32;
        u32x4 vv[4];
#pragma unroll
        for (int i = 0; i < 4; ++i) vv[i] = *(const u32x4*)(vp + 8 * i);
        LAS unsigned char* vrow = vl + (lane >> 1) * 144 + (lane & 1) * 64;
#pragma unroll
        for (int i = 0; i < 4; ++i) *(LAS u32x4*)(vrow + 16 * i) = vv[i];
        f32x16 s;
#pragma unroll
        for (int i = 0; i < 16; ++i) s[i] = 0.f;
#pragma unroll
        for (int kk = 0; kk < 4; ++kk) s = __builtin_amdgcn_mfma_f32_32x32x16_bf16(kf[kk], qf[kk], s, 0, 0, 0);
        const bool diag = (kb == q0);
        float rr[16], be[16];
#pragma unroll
        for (int i = 0; i < 16; ++i) { const int key = (i & 3) + 8 * (i >> 2) + 4 * hi; const float z = fminf(s[i], 80.f); const float e = fexp2(z * 1.44269504f); const float ri = frcp(1.f + e);
            const bool masked = diag && (key >= r); rr[i] = masked ? 1.f : ri; be[i] = masked ? 0.f : e * ri; }
        float t[4], p[4], pp[4];
#pragma unroll
        for (int g = 0; g < 4; ++g) { t[g] = (rr[4 * g] * rr[4 * g + 1]) * (rr[4 * g + 2] * rr[4 * g + 3]); { const unsigned ti_ = __builtin_bit_cast(unsigned, t[g]); const auto sw_ = __builtin_amdgcn_permlane32_swap(ti_, ti_, false, false);
              p[g] = __builtin_bit_cast(float, hi ? sw_[0] : sw_[1]); } pp[g] = t[g] * p[g]; }
        float Sx[4]; Sx[3] = 1.f; Sx[2] = pp[3]; Sx[1] = Sx[2] * pp[2]; Sx[0] = Sx[1] * pp[1];
        const float tot = Sx[0] * pp[0];
        float a[16];
#pragma unroll
        for (int g = 0; g < 4; ++g) { float E = P * Sx[g] * (hi == 0 ? p[g] : 1.f);
            a[4 * g + 3] = be[4 * g + 3] * E; E *= rr[4 * g + 3]; a[4 * g + 2] = be[4 * g + 2] * E; E *= rr[4 * g + 2]; a[4 * g + 1] = be[4 * g + 1] * E; E *= rr[4 * g + 1]; a[4 * g] = be[4 * g] * E; }
        P *= tot;
#pragma unroll
        for (int s2 = 0; s2 < 2; ++s2) {
            u32x4 ap; ap.x = pk2(a[8 * s2], a[8 * s2 + 1]); ap.y = pk2(a[8 * s2 + 2], a[8 * s2 + 3]); ap.z = pk2(a[8 * s2 + 4], a[8 * s2 + 5]); ap.w = pk2(a[8 * s2 + 6], a[8 * s2 + 7]);
            const bf16x8 af = __builtin_bit_cast(bf16x8, ap);
#pragma unroll
            for (int db = 0; db < 2; ++db) { bf16x8 vf;
#pragma unroll
                for (int j = 0; j < 8; ++j) { const int key = 16 * s2 + 8 * (j >> 2) + 4 * hi + (j & 3); vf[j] = *(const LAS short*)(vl + key * 144 + (db * 32 + r) * 2); }
                if (db == 0) o0 = __builtin_amdgcn_mfma_f32_32x32x16_bf16(vf, af, o0, 0, 0, 0); else o1 = __builtin_amdgcn_mfma_f32_32x32x16_bf16(vf, af, o1, 0, 0, 0); }
        }
        if (__all(P < 1e-12f)) break;
    }
    unsigned char* op = MIX + (tok0 + q0 + r) * DM + h * 64 + 4 * hi;
#pragma unroll
    for (int g = 0; g < 4; ++g) { int t0 = __builtin_amdgcn_cvt_pk_fp8_f32(o0[4 * g], o0[4 * g + 1], 0, false); t0 = __builtin_amdgcn_cvt_pk_fp8_f32(o0[4 * g + 2], o0[4 * g + 3], t0, true);
        int t1 = __builtin_amdgcn_cvt_pk_fp8_f32(o1[4 * g], o1[4 * g + 1], 0, false); t1 = __builtin_amdgcn_cvt_pk_fp8_f32(o1[4 * g + 2], o1[4 * g + 3], t1, true);
        *(int*)(op + 8 * g) = t0; *(int*)(op + 32 + 8 * g) = t1; }
}
__device__ __forceinline__ void conv_chunk(const bf16* U, unsigned char* MIX, const LAS float* wl, int tc, int bstart, const float* dwbp, const float* lngp, const float* lnbp, int lane) {
    f32x4 acc[8][2];
    { const f32x4 b0 = *(const f32x4*)dwbp, b1 = *(const f32x4*)(dwbp + 4);
#pragma unroll
      for (int o = 0; o < 8; ++o) { acc[o][0] = b0; acc[o][1] = b1; } }
    f32x4 W[12][2]; u32x4 raw[4];
#define CONV_LD(q, I) do { const int s_ = tc - 30 + (I); int sc_ = s_ < bstart ? bstart : s_; sc_ = sc_ > NTOK - 1 ? NTOK - 1 : sc_; const u32x4 v_ = *(const u32x4*)(U + (size_t)sc_ * 512 + 8 * lane); \
        raw[q] = (s_ >= bstart) ? v_ : (u32x4){0u, 0u, 0u, 0u}; } while (0)
#define CONV_UNPACK(q, SLOT) do { W[SLOT][0] = (f32x4){bflo(raw[q].x), bfhi(raw[q].x), bflo(raw[q].y), bfhi(raw[q].y)}; W[SLOT][1] = (f32x4){bflo(raw[q].z), bfhi(raw[q].z), bflo(raw[q].w), bfhi(raw[q].w)}; } while (0)
#pragma unroll
    for (int b3 = 0; b3 < 3; ++b3) {
#pragma unroll
        for (int q = 0; q < 4; ++q) CONV_LD(q, 4 * b3 + q);
#pragma unroll
        for (int q = 0; q < 4; ++q) if (4 * b3 + q < 11) CONV_UNPACK(q, 4 * b3 + q); }
#pragma unroll 1
    for (int S = 0; S < 3; ++S) {
#pragma unroll
        for (int gq = 0; gq < 3; ++gq) { const int G = 3 * S + gq;
            if (G <= 7) {
                if (G >= 1) {
#pragma unroll
                    for (int q = 0; q < 4; ++q) CONV_UNPACK(q, (4 * gq + 7 + q) % 12); }
                if (G <= 6) {
#pragma unroll
                    for (int q = 0; q < 4; ++q) CONV_LD(q, 12 * S + 4 * gq + 11 + q); }
#pragma unroll
                for (int jj = 0; jj < 4; ++jj) { const int j = 12 * S + 4 * gq + jj; if (j <= 30) { const LAS f32x4* wp = (const LAS f32x4*)(wl + j * 512 + 8 * lane); const f32x4 w0 = wp[0], w1 = wp[1];
#pragma unroll
                    for (int o = 0; o < 8; ++o) { acc[o][0] += w0 * W[(4 * gq + jj + o) % 12][0]; acc[o][1] += w1 * W[(4 * gq + jj + o) % 12][1]; } } }
            }
            __builtin_amdgcn_sched_barrier(0);
        }
    }
#undef CONV_LD
#undef CONV_UNPACK
    f32x4 lng[2], lnb[2]; lng[0] = *(const f32x4*)lngp; lng[1] = *(const f32x4*)(lngp + 4); lnb[0] = *(const f32x4*)lnbp; lnb[1] = *(const f32x4*)(lnbp + 4);
#pragma unroll
    for (int o = 0; o < 8; ++o) {
        const f32x4 a0 = acc[o][0], a1 = acc[o][1];
        const float mean = wave_sum((a0[0] + a0[1]) + (a0[2] + a0[3]) + (a1[0] + a1[1]) + (a1[2] + a1[3])) * (1.f / 512.f);
        const f32x4 d0 = a0 - mean, d1 = a1 - mean;
        const float var = wave_sum((d0[0] * d0[0] + d0[1] * d0[1]) + (d0[2] * d0[2] + d0[3] * d0[3]) + (d1[0] * d1[0] + d1[1] * d1[1]) + (d1[2] * d1[2] + d1[3] * d1[3])) * (1.f / 512.f);
        const float rstd = __builtin_amdgcn_rsqf(var + EPS);
        f32x4 y0 = d0 * rstd * lng[0] + lnb[0], y1 = d1 * rstd * lng[1] + lnb[1];
#pragma unroll
        for (int e = 0; e < 4; ++e) { y0[e] = y0[e] * sigmoidf_(y0[e]); y1[e] = y1[e] * sigmoidf_(y1[e]); }
        { u32x2 w; int t_ = __builtin_amdgcn_cvt_pk_fp8_f32(y0[0], y0[1], 0, false); w.x = (unsigned)__builtin_amdgcn_cvt_pk_fp8_f32(y0[2], y0[3], t_, true);
          t_ = __builtin_amdgcn_cvt_pk_fp8_f32(y1[0], y1[1], 0, false); w.y = (unsigned)__builtin_amdgcn_cvt_pk_fp8_f32(y1[2], y1[3], t_, true);
          *(u32x2*)(MIX + (size_t)(tc + o) * DM + 512 + 8 * lane) = w; }
    }
}
__device__ __forceinline__ void even_core(const Ctx& C, int l) {
    const int i = l >> 1; const int gw = C.vcu * NWAVES + C.wave, NGW = C.G * NWAVES;
    LAS float* wl = (LAS float*)(C.lds + 40960);
    { const GAS f32x4* src = (const GAS f32x4*)(VEC(V_DWW) + (size_t)i * 31 * 512); f32x4 tv[8];
#pragma unroll
      for (int q = 0; q < 8; ++q) { const int idx = C.tid + NWAVES * 64 * q; tv[q] = src[idx < 3968 ? idx : 3967]; }
#pragma unroll
      for (int q = 0; q < 8; ++q) { const int idx = C.tid + NWAVES * 64 * q; if (idx < 3968) ((LAS f32x4*)wl)[idx] = tv[q]; } }
    __syncthreads();
    const bf16* QKV = WSB(WS_QKV); unsigned char* MIX = C.ws + WS_MIX;
    LAS unsigned char* vl = C.lds + C.wave * 4608;
    for (int u = gw; u < 64 * 128; u += NGW) { const int bh = u >> 7, qb = u & 127; attn_wave_unit(QKV, MIX, bh >> 3, bh & 7, qb, vl, C.lane); }
    for (int u = gw; u < NTOK / 16; u += NGW) { const int t0 = u * 16, bstart = t0 & ~(SEQ - 1);
#pragma unroll 1
        for (int ch = 0; ch < 2; ++ch) conv_chunk(WSB(WS_UE), MIX, wl, t0 + 8 * ch, bstart, VEC(V_DWB) + i * 512 + 8 * C.lane, VEC(V_LNG) + i * 512 + 8 * C.lane, VEC(V_LNB) + i * 512 + 8 * C.lane, C.lane); }
}
__device__ __forceinline__ void odd_core(const Ctx& C) {
    const int gw = C.vcu * NWAVES + C.wave, NGW = C.G * NWAVES, lane = C.lane;
    const unsigned char* U = C.ws + WS_UO; unsigned char* PO = C.ws + WS_POOL;
    const int w = 2 << (lane >> 4);
#define ODD_UNPACK(v, c) do { const f32x4 a_ = fp8x4((v).x), b_ = fp8x4((v).y), c_ = fp8x4((v).z), d_ = fp8x4((v).w); \
        c[0] = a_[0]; c[1] = a_[1]; c[2] = a_[2]; c[3] = a_[3]; c[4] = b_[0]; c[5] = b_[1]; c[6] = b_[2]; c[7] = b_[3]; c[8] = c_[0]; c[9] = c_[1]; c[10] = c_[2]; c[11] = c_[3]; c[12] = d_[0]; c[13] = d_[1]; c[14] = d_[2]; c[15] = d_[3]; } while (0)
    for (int u = gw; u < NTOK / 16; u += NGW) {
        const int t0 = u * 16, bstart = t0 & ~(SEQ - 1);
        float S[16];
#pragma unroll
        for (int e = 0; e < 16; ++e) S[e] = 0.f;
#pragma unroll
        for (int j = 1; j < 16; ++j) { const int s = t0 - j; const bool ok = (j < w) && (s >= bstart); const int sc = s < bstart ? bstart : s;
            const u32x4 v0 = *(const u32x4*)(U + (size_t)sc * DM + 16 * lane); const float f = ok ? 1.f : 0.f; float c[16]; ODD_UNPACK(v0, c);
#pragma unroll
            for (int e = 0; e < 16; ++e) S[e] += f * c[e]; }
#pragma unroll 4
        for (int i = 0; i < 16; ++i) { const int t = t0 + i;
            const u32x4 v0 = *(const u32x4*)(U + (size_t)t * DM + 16 * lane);
            float c[16]; ODD_UNPACK(v0, c);
            const int n = t - bstart + 1; const float inv = 1.f / (float)(n < w ? n : w);
            float o[16];
#pragma unroll
            for (int e = 0; e < 16; ++e) { S[e] += c[e]; o[e] = S[e] * inv - c[e]; }
            u32x4 w0;
#pragma unroll
            for (int q = 0; q < 4; ++q) { int t_ = __builtin_amdgcn_cvt_pk_fp8_f32(o[4 * q], o[4 * q + 1], 0, false); w0[q] = (unsigned)__builtin_amdgcn_cvt_pk_fp8_f32(o[4 * q + 2], o[4 * q + 3], t_, true); }
            *(u32x4*)(PO + (size_t)t * DM + 16 * lane) = w0;
            const int old = t - w + 1; const bool ok = old >= bstart; const int oc = ok ? old : bstart; const float f = ok ? 1.f : 0.f;
            const u32x4 q0 = *(const u32x4*)(U + (size_t)oc * DM + 16 * lane); float d[16]; ODD_UNPACK(q0, d);
#pragma unroll
            for (int e = 0; e < 16; ++e) S[e] -= f * d[e]; }
    }
#undef ODD_UNPACK
}

struct Args { const float* in[25]; float* out; unsigned char* ws; int ph_lo, ph_hi; };
__global__ void __launch_bounds__(NWAVES * 64, 2) fwd(Args args) {
    extern __shared__ __attribute__((aligned(16))) unsigned char lds_raw[];
    Ctx C0;
#define C C0
    C.lds = (LAS unsigned char*)lds_raw; C.tab = (LAS int*)(C.lds + TAB_OFF);
    C.tid = threadIdx.x; C.lane = C.tid & 63; C.wave = __builtin_amdgcn_readfirstlane(C.tid >> 6);
    C.G = gridDim.x; { const int bx = blockIdx.x; C.vcu = (C.G % 8 == 0) ? (bx % 8) * (C.G / 8) + bx / 8 : bx; }
    C.xin = args.in[0]; C.w1 = args.in[18]; C.w3 = args.in[19]; C.w2 = args.in[20];
    C.X = args.out; C.ws = args.ws;
    volatile LAS unsigned* MISC = (volatile LAS unsigned*)(C.lds + MISC_OFF);
    for (int u = C.tid; u < (LDS_BYTES - TAB_OFF) / 4; u += NWAVES * 64) ((LAS unsigned*)(C.lds + TAB_OFF))[u] = 0u;
    __syncthreads();
    const int lo = args.ph_lo, hi = args.ph_hi;
    unsigned* barw = (unsigned*)(C0.ws + WS_CTL) + CW_BAR;
    XcdBarrier bar; bar.bar = barw; bar.x = 0; bar.st = nullptr;
    if (hi - lo > 1) bar = xcd_barrier_post(barw, MISC + 8);
#undef C
#define IN(k) (lo <= (k) && (k) < hi)
#define SEAM(k) do { if (IN(k) && IN((k) + 1)) xcd_barrier(bar); } while (0)

    if (IN(0)) { const Ctx C = phase_ctx(C0); prologue(C, args); }
    SEAM(0);
#pragma unroll 1
    for (int l = 0; l < DEPTH; ++l) {
        const int pb = 1 + 7 * l, i2 = l >> 1; const bool even = (l & 1) == 0;
        if (IN(pb)) { const Ctx C = phase_ctx(C0); if (l == 0) row_phase<0>(C, l); else combine_phase<false>(C, l); }
        SEAM(pb);
        if (IN(pb + 1)) { const Ctx C = phase_ctx(C0);
            if (even) { pg8::DenseSched S; S.A = (const char*)(C.ws + WS_H); S.Bt = (const char*)(C.ws + WS_WINE) + (size_t)i2 * 2560 * 1024; S.Kb = 1024; S.so.init(NTOK, 2560, C.G, (int)blockIdx.x);
                pg8::EpiEven E{WSB(WS_QKV), WSB(WS_UE)}; pg8::gemm_phase<pg8::EpiEven, pg8::DenseSched, false, true, pg8::FP8_SCALE_G1>(C.lds, 1024, S, E); }
            else { pg8::DenseSched S; S.A = (const char*)(C.ws + WS_H); S.Bt = (const char*)(C.ws + WS_WINO) + (size_t)i2 * 1024 * 1024; S.Kb = 1024; S.so.init(NTOK, 1024, C.G, (int)blockIdx.x);
                pg8::EpiPair E{C.ws + WS_UO, C.ws + WS_UO, C.ws + WS_DUMP}; pg8::gemm_phase<pg8::EpiPair, pg8::DenseSched, false, true, pg8::FP8_SCALE_G1>(C.lds, 1024, S, E); }
        }
        SEAM(pb + 1);
        if (IN(pb + 2)) { const Ctx C = phase_ctx(C0);
            if (even) even_core(C, l); else odd_core(C);
            if (l > 0) { __syncthreads(); moe_convert(C, l, (LAS float*)(C.lds + C.wave * 8448), C.vcu * NWAVES + C.wave, C.G * NWAVES); }
        }
        SEAM(pb + 2);
        if (IN(pb + 3)) { const Ctx C = phase_ctx(C0);
            pg8::DenseSched S; S.A = (const char*)(C.ws + (even ? WS_MIX : WS_POOL)); S.Bt = (const char*)(C.ws + (even ? WS_WOUTE : WS_WC)) + (size_t)i2 * 1024 * 1024; S.Kb = 1024; S.so.init(NTOK, 1024, C.G, (int)blockIdx.x);
            pg8::EpiResid E{WSB(WS_X), (const float*)(C.ws + WS_MOD) + (size_t)l * 8 * 6144 + 2 * 1024}; pg8::gemm_phase<pg8::EpiResid, pg8::DenseSched, false, true, pg8::FP8_SCALE_G1>(C.lds, 1024, S, E);
        }
        SEAM(pb + 3);
        if (IN(pb + 4)) { const Ctx C = phase_ctx(C0); row_phase<2>(C, l); }
        SEAM(pb + 4);
        if (IN(pb + 5)) { const Ctx C = phase_ctx(C0);
            build_tables(C, l);
            pg8::MoeSched S; S.tab = C.tab; S.T = C.tab[64]; S.nsplit = 2; S.nshared = 256; S.G = C.G; S.c = C.vcu; S.Kb = 1024; S.gemm1 = 1;
            S.Ash = (const char*)(C.ws + WS_H8); S.Art = S.Ash; S.Bsh = (const char*)(C.ws + WS_WS13) + (size_t)l * 512 * 1024; S.Brt = (const char*)(C.ws + WS_W13) + (size_t)(l & 1) * (32 * MiB);
            S.bstride_e = (size_t)512 * 1024; S.bstride_n = (size_t)256 * 1024; S.tokof = (const int*)(C.ws + WS_TOKOF);
            pg8::EpiSwiGLU E{C.ws + WS_HR, C.ws + WS_HS, C.ws + WS_DUMP}; pg8::gemm_phase<pg8::EpiSwiGLU, pg8::MoeSched, true, true, pg8::FP8_SCALE_G1>(C.lds, 1024, S, E);
        }
        SEAM(pb + 5);
        if (IN(pb + 6)) { const Ctx C = phase_ctx(C0);
#if MK_PER_PHASE
            build_tables(C, l);
#endif
            pg8::MoeSched S; S.tab = C.tab; S.T = C.tab[64]; S.nsplit = 4; S.nshared = 512; S.G = C.G; S.c = C.vcu; S.Kb = 256; S.gemm1 = 0; S.ashare = 1;
            S.Ash = (const char*)(C.ws + WS_HS); S.Art = (const char*)(C.ws + WS_HR); S.Bsh = (const char*)(C.ws + WS_WS2) + (size_t)l * 1024 * 256; S.Brt = (const char*)(C.ws + WS_W2) + (size_t)(l & 1) * (16 * MiB);
            S.bstride_e = (size_t)1024 * 256; S.bstride_n = (size_t)256 * 256; S.tokof = nullptr;
            pg8::EpiPair E{C.ws + WS_PAIR, C.ws + WS_SOUT, C.ws + WS_DUMP}; pg8::gemm_phase<pg8::EpiPair, pg8::MoeSched, false, true, pg8::FP8_SCALE_G2, false, true>(C.lds, 256, S, E);
        }
        SEAM(pb + 6);
    }
    if (IN(29)) { const Ctx C = phase_ctx(C0); combine_phase<true>(C, DEPTH); }
#undef IN
#undef SEAM
}

extern "C" void kernel_launch(void* const* d_in, const int* in_sizes, int n_in, void* d_out, int out_size, void* d_ws, size_t ws_size, hipStream_t stream) {
    static int grid = 0;
    if (grid == 0) {
        if (n_in != 25 || out_size != NTOK * DM || ws_size < WS_END) { fprintf(stderr, "kernel_launch: unexpected shapes (n_in %d, out %d, ws %zu < %zu); nothing launched\n", n_in, out_size, ws_size, (size_t)WS_END); grid = -1; return; }
        int dev = 0, cus = 0, per_cu = 0;
        if (hipGetDevice(&dev) != hipSuccess || hipDeviceGetAttribute(&cus, hipDeviceAttributeMultiprocessorCount, dev) != hipSuccess) { grid = -1; return; }
        if (hipFuncSetAttribute((const void*)fwd, hipFuncAttributeMaxDynamicSharedMemorySize, LDS_BYTES) != hipSuccess) { fprintf(stderr, "kernel_launch: hipFuncSetAttribute failed\n"); grid = -1; return; }
        if (hipOccupancyMaxActiveBlocksPerMultiprocessor(&per_cu, (const void*)fwd, NWAVES * 64, LDS_BYTES) != hipSuccess || per_cu < 1) fprintf(stderr, "kernel_launch: note: occupancy query reports %d\n", per_cu);
        (void)hipGetLastError();
        grid = cus;
        if (grid != 256) fprintf(stderr, "kernel_launch: note: %d CUs (tuned for 256)\n", grid);
    }
    if (grid < 0) return;
    if (hipMemsetAsync((char*)d_ws + WS_CTL, 0, CTL_ZERO_BYTES, stream) != hipSuccess) { fprintf(stderr, "kernel_launch: memset failed\n"); return; }
    Args a{};
    for (int i = 0; i < 25; ++i) a.in[i] = (const float*)d_in[i];
    a.out = (float*)d_out; a.ws = (unsigned char*)d_ws;
#if MK_PER_PHASE
    for (int p = 0; p < NPHASE; ++p) { a.ph_lo = p; a.ph_hi = p + 1; hipLaunchKernelGGL(fwd, dim3(grid), dim3(NWAVES * 64), LDS_BYTES, stream, a); }
#else
    a.ph_lo = 0; a.ph_hi = NPHASE; hipLaunchKernelGGL(fwd, dim3(grid), dim3(NWAVES * 64), LDS_BYTES, stream, a);
#endif
    const hipError_t le = hipPeekAtLastError();
    if (le != hipSuccess) fprintf(stderr, "kernel_launch: launch failed: %s\n", hipGetErrorName(le));
}
```
